# Optimizing an MI355X kernel written in HIP

```python
import jax, jax.numpy as jnp
from jax import lax
import numpy as np

D_MODEL = 1024
BATCH = 2
SEQ = 8192
DEPTH = 2
DEC_BATCH = 32
DEC_SEQ = 32
PAST_LEN = 1024

CHUNK = 64
EPS = 1e-6
NEG_INF = -1e30
ROPE_BASE = 10000.0
Q_BLOCK = 128
RET_HEADS = 4
RET_DK = 64
RET_DV = 64
RET_W = RET_HEADS * RET_DV
MLA_HEADS = 8
MLA_NOPE = 64
MLA_ROPE = 32
MLA_V = 64
MLA_QK = MLA_NOPE + MLA_ROPE
Q_LORA = 256
KV_LORA = 128
MLA_W = MLA_HEADS * MLA_V
BAND_HEADS = 4
BAND_DH = 64
BAND_W = BAND_HEADS * BAND_DH
BAND_PREV_CHUNKS = 8
BAND_PAST = BAND_PREV_CHUNKS * CHUNK
BAND_KEYS = BAND_PAST + CHUNK
MAX_REL = 128
N_REL = 2 * MAX_REL + 1
D_MIX = RET_W + MLA_W + BAND_W
_SEG = (RET_HEADS * RET_DK, RET_HEADS * RET_DK, RET_W, RET_W,
        Q_LORA, KV_LORA, MLA_ROPE, MLA_W,
        BAND_W, BAND_W, BAND_W, BAND_W)
D_IN = sum(_SEG)

kernel_name = 'hybrid_retention_mla_chunkband_stream_step'


def _rmsnorm(x, g):
    xf = x.astype(jnp.float32)
    y = xf * lax.rsqrt(jnp.mean(xf * xf, axis=-1, keepdims=True) + EPS)
    return (y * g.astype(jnp.float32)).astype(x.dtype)


def _rope(x, pos):
    half = x.shape[-1] // 2
    inv = ROPE_BASE ** (-jnp.arange(half, dtype=jnp.float32) / half)
    ang = pos.astype(jnp.float32)[:, None] * inv[None, :]
    cos = jnp.cos(ang)[None, :, None, :]
    sin = jnp.sin(ang)[None, :, None, :]
    xf = x.astype(jnp.float32)
    x1, x2 = xf[..., :half], xf[..., half:]
    return jnp.concatenate([x1 * cos - x2 * sin, x1 * sin + x2 * cos], axis=-1).astype(x.dtype)


def _project(x, norm_g, w_in):
    h = _rmsnorm(x, norm_g)
    z = jnp.einsum('btd,de->bte', h, w_in)
    cuts, acc = [], 0
    for s in _SEG[:-1]:
        acc += s
        cuts.append(acc)
    return jnp.split(z, cuts, axis=-1)


def _ret_log_gamma():
    return jnp.log1p(-jnp.exp2(-5.0 - jnp.arange(RET_HEADS, dtype=jnp.float32)))


def _retention_block(q, k, v, S):
    q = q.astype(jnp.float32)
    k = k.astype(jnp.float32)
    v = v.astype(jnp.float32)
    S = S.astype(jnp.float32)
    L = q.shape[1]
    lg = _ret_log_gamma()
    idx = jnp.arange(L, dtype=jnp.float32)
    diff = idx[:, None] - idx[None, :]
    dmask = jnp.where(diff >= 0, jnp.exp(lg[:, None, None] * jnp.maximum(diff, 0.0)), 0.0)
    inner = jnp.einsum('blhd,bmhd->bhlm', q, k) * dmask[None]
    o = jnp.einsum('bhlm,bmhe->blhe', inner, v)
    xi = jnp.exp(lg[None, :] * (idx[:, None] + 1.0))
    o = o + jnp.einsum('blhd,bhde->blhe', q, S) * xi[None, :, :, None]
    zeta = jnp.exp(lg[None, :] * (L - 1.0 - idx)[:, None])
    S_new = (jnp.exp(lg * L)[None, :, None, None] * S
             + jnp.einsum('blhd,blhe->bhde', k * zeta[None, :, :, None], v))
    return o, S_new


def _retention_prompt(q, k, v):
    B, S, H, dk = q.shape
    nc = S // CHUNK

    def to_chunks(t):
        return t.reshape(B, nc, CHUNK, H, t.shape[-1]).swapaxes(0, 1)

    S0 = jnp.zeros((B, H, dk, v.shape[-1]), jnp.float32)

    def step(state, qkv):
        o, state = _retention_block(qkv[0], qkv[1], qkv[2], state)
        return state, o

    S_fin, o = lax.scan(step, S0, (to_chunks(q), to_chunks(k), to_chunks(v)))
    return o.swapaxes(0, 1).reshape(B, S, H, v.shape[-1]), S_fin


def _mla_prompt_attn(q, k, v):
    B, S, H, dq = q.shape
    nb = S // Q_BLOCK
    scale = dq ** -0.5
    key_chunk = jnp.arange(S) // CHUNK
    qb = q.reshape(B, nb, Q_BLOCK, H, dq).swapaxes(0, 1)

    def one_block(args):
        q_blk, b_idx = args
        q_chunk = (b_idx * Q_BLOCK + jnp.arange(Q_BLOCK)) // CHUNK
        s = jnp.einsum('bqhd,bkhd->bhqk', q_blk, k).astype(jnp.float32) * scale
        s = jnp.where(key_chunk[None, :] <= q_chunk[:, None], s, NEG_INF)
        p = jax.nn.softmax(s, axis=-1).astype(v.dtype)
        return jnp.einsum('bhqk,bkhd->bqhd', p, v)

    o = lax.map(one_block, (qb, jnp.arange(nb)))
    return o.swapaxes(0, 1).reshape(B, S, H, v.shape[-1])


def _dense_attn(q, k, v, bias):
    s = jnp.einsum('bqhd,bkhd->bhqk', q, k).astype(jnp.float32) * (q.shape[-1] ** -0.5)
    if bias is not None:
        s = s + bias[None].astype(jnp.float32)
    p = jax.nn.softmax(s, axis=-1).astype(v.dtype)
    return jnp.einsum('bhqk,bkhd->bqhd', p, v)


def _band_prompt_attn(q, k, v, band_bias):
    B, S, H, d = q.shape
    nc = S // CHUNK

    def gather_band(t):
        tc = t.reshape(B, nc, CHUNK, H, d)
        tp = jnp.pad(tc, ((0, 0), (BAND_PREV_CHUNKS, 0), (0, 0), (0, 0), (0, 0)))
        return jnp.concatenate([tp[:, j:j + nc] for j in range(BAND_PREV_CHUNKS + 1)], axis=2)

    kb, vb = gather_band(k), gather_band(v)
    qc = q.reshape(B, nc, CHUNK, H, d)
    s = jnp.einsum('bcqhd,bckhd->bchqk', qc, kb).astype(jnp.float32) * (d ** -0.5)
    qi = jnp.arange(CHUNK)
    kj = jnp.arange(BAND_KEYS)
    dist = qi[:, None] + BAND_PAST - kj[None, :]
    bias = band_bias[:, jnp.clip(dist, -MAX_REL, MAX_REL) + MAX_REL]
    s = s + bias[None, None].astype(jnp.float32)
    key_chunk = jnp.arange(nc)[:, None] - BAND_PREV_CHUNKS + kj[None, :] // CHUNK
    s = jnp.where((key_chunk >= 0)[None, :, None, None, :], s, NEG_INF)
    p = jax.nn.softmax(s, axis=-1).astype(v.dtype)
    o = jnp.einsum('bchqk,bckhd->bcqhd', p, vb)
    return o.reshape(B, S, H, d)


def _layer(x, pos, norm_g, w_in, ret_gn_g, mla_qa_g, mla_w_uq, mla_qn_g, mla_qr_g,
           mla_kva_g, mla_kr_g, mla_w_ukv, mla_kn_g, band_qn_g, band_kn_g, band_bias,
           w_out, past):
    B, L, _ = x.shape
    (a_q, a_k, a_v, a_g, b_cq, b_ckv, b_kr, b_g,
     c_q, c_k, c_v, c_g) = _project(x, norm_g, w_in)

    q = _rope(a_q.reshape(B, L, RET_HEADS, RET_DK), pos)
    k = _rope(a_k.reshape(B, L, RET_HEADS, RET_DK), pos) * (RET_DK ** -0.5)
    v = a_v.reshape(B, L, RET_HEADS, RET_DV)
    if past is None:
        ret_o, ret_s = _retention_prompt(q, k, v)
    else:
        ret_o, ret_s = _retention_block(q, k, v, past[0])
    ret_o = _rmsnorm(ret_o, ret_gn_g.reshape(RET_HEADS, RET_DV)).astype(x.dtype).reshape(B, L, RET_W)

    cq = _rmsnorm(b_cq, mla_qa_g)
    qf = jnp.einsum('btr,re->bte', cq, mla_w_uq).reshape(B, L, MLA_HEADS, MLA_QK)
    q_m = jnp.concatenate([_rmsnorm(qf[..., :MLA_NOPE], mla_qn_g),
                           _rope(_rmsnorm(qf[..., MLA_NOPE:], mla_qr_g), pos)], axis=-1)
    ckv_new = _rmsnorm(b_ckv, mla_kva_g)
    kr_new = _rope(_rmsnorm(b_kr, mla_kr_g)[:, :, None, :], pos)[:, :, 0, :]
    if past is None:
        ckv_all, kr_all = ckv_new, kr_new
    else:
        ckv_all = jnp.concatenate([past[1], ckv_new], axis=1)
        kr_all = jnp.concatenate([past[2], kr_new], axis=1)
    T = ckv_all.shape[1]
    kv = jnp.einsum('btc,ce->bte', ckv_all, mla_w_ukv).reshape(B, T, MLA_HEADS, MLA_NOPE + MLA_V)
    k_m = jnp.concatenate([_rmsnorm(kv[..., :MLA_NOPE], mla_kn_g),
                           jnp.broadcast_to(kr_all[:, :, None, :], (B, T, MLA_HEADS, MLA_ROPE))], axis=-1)
    v_m = kv[..., MLA_NOPE:]
    if past is None:
        mla_o = _mla_prompt_attn(q_m, k_m, v_m)
    else:
        mla_o = _dense_attn(q_m, k_m, v_m, None)
    mla_o = mla_o.reshape(B, L, MLA_W)

    qb = _rmsnorm(c_q.reshape(B, L, BAND_HEADS, BAND_DH), band_qn_g)
    kb = _rmsnorm(c_k.reshape(B, L, BAND_HEADS, BAND_DH), band_kn_g)
    vb = c_v.reshape(B, L, BAND_HEADS, BAND_DH)
    if past is None:
        band_o = _band_prompt_attn(qb, kb, vb, band_bias)
        n_keep = min(BAND_PAST, L)
        band_k_state, band_v_state = kb[:, L - n_keep:], vb[:, L - n_keep:]
    else:
        n_c = past[3].shape[1]
        k_all = jnp.concatenate([past[3], kb], axis=1)
        v_all = jnp.concatenate([past[4], vb], axis=1)
        kpos = jnp.concatenate([pos[0] - n_c + jnp.arange(n_c), pos])
        dist = pos[:, None] - kpos[None, :]
        bias = band_bias[:, jnp.clip(dist, -MAX_REL, MAX_REL) + MAX_REL]
        band_o = _dense_attn(qb, k_all, v_all, bias)
        band_k_state, band_v_state = kb, vb
    band_o = band_o.reshape(B, L, BAND_W)

    mix = jnp.concatenate([ret_o * jax.nn.silu(a_g),
                           mla_o * jax.nn.silu(b_g),
                           band_o * jax.nn.silu(c_g)], axis=-1)
    y = x + jnp.einsum('bte,ed->btd', mix, w_out)
    return y, (ret_s.astype(x.dtype), ckv_new, kr_new, band_k_state, band_v_state)


def setup_inputs(seed: int = 0) -> dict:
    key = jax.random.key(seed)
    ks = jax.random.split(key, 24)

    def nrm(k, shape, s=1.0):
        return s * jax.random.normal(k, shape, jnp.float32)

    def gain(k, shape):
        return 1.0 + 0.1 * jax.random.normal(k, shape, jnp.float32)

    band_cache = min(BAND_PAST, PAST_LEN)
    return {
        'x_prompt': nrm(ks[0], (BATCH, SEQ, D_MODEL)),
        'x_sample': nrm(ks[1], (DEC_BATCH, DEC_SEQ, D_MODEL)),
        'state_ret': nrm(ks[2], (DEPTH, DEC_BATCH, RET_HEADS, RET_DK, RET_DV), 0.3),
        'cache_mla_ckv': nrm(ks[3], (DEPTH, DEC_BATCH, PAST_LEN, KV_LORA)),
        'cache_mla_krope': nrm(ks[4], (DEPTH, DEC_BATCH, PAST_LEN, MLA_ROPE)),
        'cache_band_k': nrm(ks[5], (DEPTH, DEC_BATCH, band_cache, BAND_HEADS, BAND_DH)),
        'cache_band_v': nrm(ks[6], (DEPTH, DEC_BATCH, band_cache, BAND_HEADS, BAND_DH)),
        'norm_g': gain(ks[7], (DEPTH, D_MODEL)),
        'w_in': nrm(ks[8], (DEPTH, D_MODEL, D_IN), D_MODEL ** -0.5),
        'ret_gn_g': gain(ks[9], (DEPTH, RET_W)),
        'mla_qa_g': gain(ks[10], (DEPTH, Q_LORA)),
        'mla_w_uq': nrm(ks[11], (DEPTH, Q_LORA, MLA_HEADS * MLA_QK), Q_LORA ** -0.5),
        'mla_qn_g': gain(ks[12], (DEPTH, MLA_NOPE)),
        'mla_qr_g': gain(ks[13], (DEPTH, MLA_ROPE)),
        'mla_kva_g': gain(ks[14], (DEPTH, KV_LORA)),
        'mla_kr_g': gain(ks[15], (DEPTH, MLA_ROPE)),
        'mla_w_ukv': nrm(ks[16], (DEPTH, KV_LORA, MLA_HEADS * (MLA_NOPE + MLA_V)), KV_LORA ** -0.5),
        'mla_kn_g': gain(ks[17], (DEPTH, MLA_NOPE)),
        'band_qn_g': gain(ks[18], (DEPTH, BAND_DH)),
        'band_kn_g': gain(ks[19], (DEPTH, BAND_DH)),
        'band_bias': nrm(ks[20], (DEPTH, BAND_HEADS, N_REL), 0.1),
        'w_out': nrm(ks[21], (DEPTH, D_MIX, D_MODEL), D_MIX ** -0.5),
    }


def reference(x_prompt, x_sample, state_ret, cache_mla_ckv, cache_mla_krope, cache_band_k,
              cache_band_v, norm_g, w_in, ret_gn_g, mla_qa_g, mla_w_uq, mla_qn_g, mla_qr_g,
              mla_kva_g, mla_kr_g, mla_w_ukv, mla_kn_g, band_qn_g, band_kn_g, band_bias, w_out):
    past_len = cache_mla_ckv.shape[2]
    pos_p = jnp.arange(x_prompt.shape[1])
    pos_s = past_len + jnp.arange(x_sample.shape[1])
    xp, xs = x_prompt, x_sample
    p_st, s_st = [], []
    for l in range(DEPTH):
        w = (norm_g[l], w_in[l], ret_gn_g[l], mla_qa_g[l], mla_w_uq[l], mla_qn_g[l], mla_qr_g[l],
             mla_kva_g[l], mla_kr_g[l], mla_w_ukv[l], mla_kn_g[l], band_qn_g[l], band_kn_g[l],
             band_bias[l], w_out[l])
        xp, sp = _layer(xp, pos_p, *w, None)
        xs, ss = _layer(xs, pos_s, *w, (state_ret[l], cache_mla_ckv[l], cache_mla_krope[l],
                                        cache_band_k[l], cache_band_v[l]))
        p_st.append(sp)
        s_st.append(ss)
    p_state_ret = jnp.stack([s[0] for s in p_st])
    p_mla_ckv = jnp.stack([s[1] for s in p_st])
    p_mla_krope = jnp.stack([s[2] for s in p_st])
    p_band_k = jnp.stack([s[3] for s in p_st])
    p_band_v = jnp.stack([s[4] for s in p_st])
    s_state_ret = jnp.stack([s[0] for s in s_st])
    s_mla_ckv = jnp.stack([s[1] for s in s_st])
    s_mla_krope = jnp.stack([s[2] for s in s_st])
    s_band_k = jnp.stack([s[3] for s in s_st])
    s_band_v = jnp.stack([s[4] for s in s_st])
    return (xp, xs, p_state_ret, p_mla_ckv, p_mla_krope, p_band_k, p_band_v,
            s_state_ret, s_mla_ckv, s_mla_krope, s_band_k, s_band_v)
```

```cpp
#include <hip/hip_runtime.h>
#include <hip/hip_cooperative_groups.h>
#include <cstdio>
namespace cg = cooperative_groups;
#ifndef DUP
#define DUP 0
#endif

typedef unsigned short u16;
typedef __attribute__((ext_vector_type(8))) short bf16x8;
typedef __attribute__((ext_vector_type(4))) short bf16x4;
typedef __attribute__((ext_vector_type(4))) float f32x4;
typedef __attribute__((ext_vector_type(2))) float f32x2;
typedef __attribute__((ext_vector_type(2))) __bf16 bfx2;
#define DI __device__ __forceinline__
#define MFMA(a, b, c) __builtin_amdgcn_mfma_f32_16x16x32_bf16((a), (b), (c), 0, 0, 0)

constexpr int NROW = 17408;
constexpr int PROW = 16384;
constexpr int KVROWS = 50176;
constexpr int BKROWS = 33792;
constexpr float EPSV = 1e-6f;
constexpr float LOG2E = 1.4426950408889634f;
constexpr float LOG2_1E4 = 13.287712379549449f;

constexpr size_t O_Y = 0;
constexpr size_t O_PSTATE = 17825792;
constexpr size_t O_PCKV = 17891328;
constexpr size_t O_PKR = 22085632;
constexpr size_t O_PBK = 23134208;
constexpr size_t O_PBV = 23658496;
constexpr size_t O_SSTATE = 24182784;
constexpr size_t O_SCKV = 25231360;
constexpr size_t O_SKR = 25493504;
constexpr size_t O_SBK = 25559040;
constexpr size_t O_SBV = 26083328;

constexpr size_t W_WIN = 0;
constexpr size_t W_WUQ = W_WIN + 3072ull * 1024 * 2;
constexpr size_t W_WUKV = W_WUQ + 768ull * 256 * 2;
constexpr size_t W_WOUT = W_WUKV + 1024ull * 128 * 2;
constexpr size_t W_H = W_WOUT + 1024ull * 1024 * 2;
constexpr size_t W_RETQ = W_H + (size_t)NROW * 1024 * 2;
constexpr size_t W_RETK = W_RETQ + (size_t)NROW * 256 * 2;
constexpr size_t W_RETVT = W_RETK + (size_t)NROW * 256 * 2;
constexpr size_t W_GATE = W_RETVT + (size_t)NROW * 256 * 2;
constexpr size_t W_KR = W_GATE + (size_t)NROW * 1024 * 2;
constexpr size_t W_KNOPE = W_KR + (size_t)KVROWS * 32 * 2;
constexpr size_t W_VT = W_KNOPE + (size_t)KVROWS * 512 * 2;
constexpr size_t W_KVEND = W_VT + (size_t)KVROWS * 512 * 2;
constexpr size_t W_ZRAW = W_KNOPE;
constexpr size_t W_RETKZT = W_ZRAW + (size_t)NROW * 416 * 4;
constexpr size_t W_BQ = W_RETKZT + (size_t)NROW * 256 * 2;
constexpr size_t W_BK = W_BQ + (size_t)NROW * 256 * 2;
constexpr size_t W_BVT = W_BK + (size_t)BKROWS * 256 * 2;
static_assert(W_BVT + (size_t)BKROWS * 256 * 2 <= W_KVEND, "alias overflow");
constexpr size_t W_CQ = W_KVEND;
constexpr size_t W_CKV = W_CQ + (size_t)NROW * 256 * 2;
constexpr size_t W_KVC = W_CKV + (size_t)KVROWS * 128 * 2;
constexpr size_t W_SST = W_KVC + 1152ull * 4096 * 4;
constexpr size_t W_CTR = W_SST + 1152ull * 4096 * 2;
constexpr size_t W_BAR = W_CTR + 4096;
constexpr size_t W_TOTAL = W_BAR + 16384;
static_assert(W_TOTAL <= 268435456ull, "workspace too large");

struct Params {
  const float* in[22];
  float* out;
  char* ws;
};

DI int otid() { int t = __builtin_amdgcn_workitem_id_x(); asm volatile("" : "+v"(t)); return t; }
DI int olayer(int l) { asm volatile("" : "+s"(l)); return l; }
DI unsigned pack2(float a, float b) {
  f32x2 v = {a, b};
  bfx2 r = __builtin_convertvector(v, bfx2);
  return __builtin_bit_cast(unsigned, r);
}
DI u16 f2bf(float a) { return (u16)(pack2(a, 0.f) & 0xffffu); }
DI bf16x4 pack4(float a, float b, float c, float d) {
  uint2 u = make_uint2(pack2(a, b), pack2(c, d));
  return __builtin_bit_cast(bf16x4, u);
}
DI float4 ntld4(const float* p) { f32x4 v = __builtin_nontemporal_load((const f32x4*)p); return make_float4(v[0], v[1], v[2], v[3]); }
DI float ntld1(const float* p) { return __builtin_nontemporal_load(p); }
DI void ntst4(float* p, float4 v) { f32x4 t = {v.x, v.y, v.z, v.w}; __builtin_nontemporal_store(t, (f32x4*)p); }
DI float bf2f(u16 v) { return __uint_as_float(((unsigned)v) << 16); }
DI float ex2(float x) { return __builtin_amdgcn_exp2f(x); }
DI float gamma_lg2(int h) {
  return h == 0 ? -0.04580368961312479f : (h == 1 ? -0.02272007650008353f : (h == 2 ? -0.011315313227834146f : -0.005646563141142063f));
}
DI void rope_cs(int pos, int i, float neg_l2b_over_half, float& c, float& s) {
  float inv = ex2((float)i * neg_l2b_over_half);
  float ang = (float)pos * inv;
  const float CH = 0.15915493667125702f, CL = 6.420638326565253e-09f;
  float rev = ang * CH;
  float err = fmaf(ang, CH, -rev) + ang * CL;
  float fr = (rev - rintf(rev)) + err;
  s = __builtin_amdgcn_sinf(fr);
  c = __builtin_amdgcn_cosf(fr);
}
DI void row_info(int row, int& seq, int& t, int& pos) {
  if (row < PROW) { seq = row >> 13; t = row & 8191; pos = t; }
  else { int r = row - PROW; seq = 2 + (r >> 5); t = r & 31; pos = 1024 + t; }
}
template <int CTRL>
DI float dppf(float v) { return __builtin_bit_cast(float, __builtin_amdgcn_update_dpp(0, __builtin_bit_cast(int, v), CTRL, 0xf, 0xf, false)); }
DI float red16(float v) {
  v += dppf<0x128>(v); v += dppf<0x124>(v); v += dppf<0x122>(v); v += dppf<0x121>(v);
  return v;
}
DI float redg(float v) {
  v += __shfl_xor(v, 16); v += __shfl_xor(v, 32);
  return v;
}
DI float red64(float v) { return redg(red16(v)); }
DI float silu(float x) { return x * __builtin_amdgcn_rcpf(1.f + ex2(-x * LOG2E)); }

DI size_t ret_t_addr(int seq, int t, int h, int d) {
  return seq < 2 ? ((size_t)((seq * 4 + h) * 64 + d) * 8192 + t) : (4194304ull + (size_t)(((seq - 2) * 4 + h) * 64 + d) * 32 + t);
}
DI size_t band_t_addr(int seq, int tk, int h, int d) {
  return seq < 2 ? ((size_t)((seq * 4 + h) * 64 + d) * 8192 + tk) : (4194304ull + (size_t)(((seq - 2) * 4 + h) * 64 + d) * 544 + tk);
}
DI size_t mla_t_addr(int seq, int tk, int h, int d) {
  return seq < 2 ? ((size_t)((seq * 8 + h) * 64 + d) * 8192 + tk) : (8388608ull + (size_t)(((seq - 2) * 8 + h) * 64 + d) * 1056 + tk);
}

#define XB_TMO      128
#define XB_XCNT(j)  (256  + 64 * (j))
#define XB_XSUB(j)  (1280 + 64 * (j))
#define XB_XGEN(j)  (2304 + 64 * (j))
#define XB_TOP      3328
#define XB_TOPGEN   3392
#define XCD_BAR_WORDS 3456
#define XB_SPIN_CAP (1u << 22)
#define LAS __attribute__((address_space(3)))
DI unsigned xb_ld(unsigned* p) { return __hip_atomic_load(p, __ATOMIC_RELAXED, __HIP_MEMORY_SCOPE_AGENT); }
DI unsigned xb_add(unsigned* p, unsigned v) { return __hip_atomic_fetch_add(p, v, __ATOMIC_RELAXED, __HIP_MEMORY_SCOPE_AGENT); }
DI unsigned xb_xcc_id() { return (unsigned)__builtin_amdgcn_s_getreg((3 << 11) | 20) & 0xFu; }
#define XB_SPIN(cond, bar) do { unsigned _sp = 0; while (cond) { __builtin_amdgcn_s_sleep(1); \
    if ((++_sp & 255u) == 0u) { if (xb_ld(&(bar)[XB_TMO])) break; if (_sp > XB_SPIN_CAP) { atomicAdd(&(bar)[XB_TMO], 1u); break; } } } } while (0)
struct XcdBarrier { unsigned* bar; unsigned x; volatile LAS unsigned* st; };
DI XcdBarrier xcd_barrier_post(unsigned* bar, volatile LAS unsigned* st) {
  XcdBarrier b; b.bar = bar; b.x = xb_xcc_id(); b.st = st;
  if (__builtin_amdgcn_workitem_id_x() == 0) (void)xb_add(&bar[XB_XCNT(b.x)], 1u);
  return b;
}
DI void xcd_barrier_complete(unsigned* bar, unsigned x, unsigned& nloc, unsigned& nx) {
  const unsigned G = gridDim.x;
  unsigned sum, cnt, mine, sp = 0u;
  for (;;) {
    sum = 0u; cnt = 0u; mine = 0u;
#pragma unroll
    for (unsigned j = 0; j < 16; ++j) { const unsigned c = xb_ld(&bar[XB_XCNT(j)]); sum += c; cnt += (c > 0u) ? 1u : 0u; mine = (j == x) ? c : mine; }
    if (sum == G) break;
    __builtin_amdgcn_s_sleep(1);
    if ((++sp & 255u) == 0u) { if (xb_ld(&bar[XB_TMO])) break; if (sp > XB_SPIN_CAP) { atomicAdd(&bar[XB_TMO], 1u); break; } }
  }
  nloc = mine > 0u ? mine : 1u; nx = cnt > 0u ? cnt : 1u;
}
DI void xcd_barrier(const XcdBarrier& b) {
  asm volatile("s_waitcnt vmcnt(0)" ::: "memory");
  __syncthreads();
  if (__builtin_amdgcn_workitem_id_x() == 0) {
    unsigned* bar = b.bar;
    __builtin_amdgcn_s_waitcnt(0);
    unsigned nloc = b.st[0], nx = b.st[1];
    if (nloc == 0u) { xcd_barrier_complete(bar, b.x, nloc, nx); b.st[0] = nloc; b.st[1] = nx; }
    const unsigned old = xb_add(&bar[XB_XSUB(b.x)], 1u);
    const unsigned gen = old / nloc;
    if (old + 1u == (gen + 1u) * nloc) {
      __builtin_amdgcn_fence(__ATOMIC_RELEASE, "agent");
      asm volatile("s_waitcnt vmcnt(0)" ::: "memory");
      const unsigned og = xb_add(&bar[XB_TOP], 1u);
      const unsigned tg = og / nx;
      if (og + 1u == (tg + 1u) * nx) xb_add(&bar[XB_TOPGEN], 1u);
      else XB_SPIN(xb_ld(&bar[XB_TOPGEN]) == tg, bar);
      __builtin_amdgcn_fence(__ATOMIC_ACQUIRE, "agent");
      xb_add(&bar[XB_XGEN(b.x)], 1u);
      asm volatile("s_waitcnt vmcnt(0)" ::: "memory");
    } else {
      XB_SPIN(xb_ld(&bar[XB_XGEN(b.x)]) == gen, bar);
      __builtin_amdgcn_fence(__ATOMIC_ACQUIRE, "agent");
      asm volatile("s_waitcnt vmcnt(0)" ::: "memory");
    }
  }
  __syncthreads();
}

constexpr int GSTAGE_B = 16384;
#define RAW_BARRIER() do { asm volatile("s_waitcnt lgkmcnt(0)" ::: "memory"); __builtin_amdgcn_s_barrier(); } while (0)
DI void gemm_core(const u16* __restrict__ A, int lda, const u16* __restrict__ Bt, int ldb, int K, int m0, int n0,
                  f32x4 (&acc)[4][4], char* smem) {
  const int tid = otid(), lane = tid & 63, wave = __builtin_amdgcn_readfirstlane(tid >> 6);
  const int wm = wave >> 1, wn = wave & 1, l15 = lane & 15, g = lane >> 4;
  const int r0 = wave * 32 + (lane >> 2);
  const int cs = ((lane & 3) ^ ((r0 >> 2) & 3)) * 8;
  const u16* ap0 = A + (size_t)(m0 + r0) * lda + cs;
  const u16* ap1 = ap0 + (size_t)16 * lda;
  const u16* bp0 = Bt + (size_t)(n0 + r0) * ldb + cs;
  const u16* bp1 = bp0 + (size_t)16 * ldb;
  char* ldsA = smem + (wave * 32) * 64;
#pragma unroll
  for (int mt = 0; mt < 4; ++mt)
#pragma unroll
    for (int nt = 0; nt < 4; ++nt) acc[mt][nt] = f32x4{0.f, 0.f, 0.f, 0.f};
#define GL(stg, k) { \
    __builtin_amdgcn_global_load_lds((const unsigned*)(ap0 + (k)), (unsigned*)(ldsA + (stg) * GSTAGE_B), 16, 0, 0); \
    __builtin_amdgcn_global_load_lds((const unsigned*)(ap1 + (k)), (unsigned*)(ldsA + (stg) * GSTAGE_B + 1024), 16, 0, 0); \
    __builtin_amdgcn_global_load_lds((const unsigned*)(bp0 + (k)), (unsigned*)(ldsA + (stg) * GSTAGE_B + 8192), 16, 0, 0); \
    __builtin_amdgcn_global_load_lds((const unsigned*)(bp1 + (k)), (unsigned*)(ldsA + (stg) * GSTAGE_B + 8192 + 1024), 16, 0, 0); }
  const int co = (g ^ (l15 >> 2)) * 16;
  const int arow = (wm * 64 + l15) * 64 + co, brow = 8192 + (wn * 64 + l15) * 64 + co;
  const int kmask = K - 1;
  const int kofs = ((int)(blockIdx.x >> 3) * 64) & kmask;
  const int nstep = K >> 5;
  const unsigned lds_base = (unsigned)(size_t)smem;
  __syncthreads();
  GL(0, kofs)
  GL(1, ((kofs + 32) & kmask))
  GL(2, ((kofs + 64) & kmask))
  for (int t = 0; t < nstep; ++t) {
    asm volatile("s_waitcnt vmcnt(8)" ::: "memory");
    RAW_BARRIER();
    GL(((t + 3) & 3), ((kofs + (t + 3) * 32) & kmask))
    const unsigned aaddr = lds_base + (t & 3) * GSTAGE_B + arow, baddr = lds_base + (t & 3) * GSTAGE_B + brow;
    bf16x8 af[4], bfr[4];
    asm volatile("ds_read_b128 %0, %8\n\tds_read_b128 %1, %8 offset:1024\n\tds_read_b128 %2, %8 offset:2048\n\tds_read_b128 %3, %8 offset:3072\n\t"
                 "ds_read_b128 %4, %9\n\tds_read_b128 %5, %9 offset:1024\n\tds_read_b128 %6, %9 offset:2048\n\tds_read_b128 %7, %9 offset:3072\n\t"
                 "s_waitcnt lgkmcnt(0)"
                 : "=&v"(af[0]), "=&v"(af[1]), "=&v"(af[2]), "=&v"(af[3]), "=&v"(bfr[0]), "=&v"(bfr[1]), "=&v"(bfr[2]), "=&v"(bfr[3])
                 : "v"(aaddr), "v"(baddr)
                 : "memory");
#pragma unroll
    for (int mt = 0; mt < 4; ++mt)
#pragma unroll
      for (int nt = 0; nt < 4; ++nt) acc[mt][nt] = MFMA(af[mt], bfr[nt], acc[mt][nt]);
  }
  asm volatile("s_waitcnt vmcnt(0)" ::: "memory");
}

template <class F>
DI void for_gemm_tiles(int MP, int NT, F f) {
  const int G = gridDim.x, bid = blockIdx.x;
  const int nx = G >> 3, xcd = bid & 7, loc = bid >> 3;
  const int mpx = MP >> 3, per = mpx * NT;
  for (int i = loc; i < per; i += nx) f(xcd * mpx + i / NT, i % NT);
}

template <class F>
DI void gemm_tiles_dyn(int* ctr, int* s_item, int xcd, int MP, int NT, F f) {
  const int tid = otid();
  const int mpx = MP >> 3, per = mpx * NT;
  for (int qi = 0; qi < 8; ++qi) {
    const int xq = (xcd + qi) & 7;
    for (;;) {
      __syncthreads();
      if (tid == 0) *s_item = atomicAdd(ctr + xq * 32, 1);
      __syncthreads();
      const int i = __builtin_amdgcn_readfirstlane(*s_item);
      if (i >= per) break;
      if ((NT & 7) == 0) {
        const int grp = mpx * 8, ng = i / grp, r = i - ng * grp;
        f(xq * mpx + (r >> 3), ng * 8 + (r & 7));
      } else f(xq * mpx + i / NT, i % NT);
    }
  }
}

DI void transpose_tile(const float* __restrict__ src, int srcN, int k0, int srcn0, bool zero, u16* dst, int dstK, int dn0, char* smem) {
  u16* t = (u16*)smem;
  const int tid = otid();
  __syncthreads();
  const int nn = tid & 31, kb = tid >> 5;
#pragma unroll
  for (int i = 0; i < 8; ++i) {
    int kk = kb + i * 8;
    float v = zero ? 0.f : ntld1(src + (size_t)(k0 + kk) * srcN + srcn0 + nn);
    t[nn * 72 + kk] = f2bf(v);
  }
  __syncthreads();
  const int r = tid >> 3, c = (tid & 7) * 8;
  *(uint4*)(dst + (size_t)(dn0 + r) * dstK + k0 + c) = *(const uint4*)(t + r * 72 + c);
}

DI void phase0(const Params& p, int l, char* smem) {
  const int G = gridDim.x, bid = blockIdx.x, tid = otid(), lane = tid & 63, wave = tid >> 6;
  char* ws = p.ws;
  {
    const float* w_in = p.in[8] + (size_t)l * 1024 * 2976;
    const float* w_uq = p.in[11] + (size_t)l * 256 * 768;
    const float* w_ukv = p.in[16] + (size_t)l * 128 * 1024;
    const float* w_out = p.in[21] + (size_t)l * 1024 * 1024;
    for (int it = bid; it < 2208; it += G) {
      if (it < 1536) {
        int nt = it >> 4, kt = it & 15, dn = nt * 32;
        int sn = dn < 1408 ? dn : (dn < 2944 ? dn + 32 : dn - 1536);
        bool zero = dn >= 2976;
        transpose_tile(w_in, 2976, kt * 64, zero ? 0 : sn, zero, (u16*)(ws + W_WIN), 1024, dn, smem);
      } else if (it < 1632) {
        int j = it - 1536, nt = j >> 2, kt = j & 3, dn = nt * 32;
        int sn = dn < 512 ? ((dn >> 6) * 96 + (dn & 63)) : (((dn - 512) >> 5) * 96 + 64);
        transpose_tile(w_uq, 768, kt * 64, sn, false, (u16*)(ws + W_WUQ), 256, dn, smem);
      } else if (it < 1696) {
        int j = it - 1632, nt = j >> 1, kt = j & 1;
        transpose_tile(w_ukv, 1024, kt * 64, nt * 32, false, (u16*)(ws + W_WUKV), 128, nt * 32, smem);
      } else {
        int j = it - 1696, nt = j >> 4, kt = j & 15;
        transpose_tile(w_out, 1024, kt * 64, nt * 32, false, (u16*)(ws + W_WOUT), 1024, nt * 32, smem);
      }
    }
  }
  {
    const float* __restrict__ ng = p.in[7] + l * 1024;
    u16* __restrict__ hbuf = (u16*)(ws + W_H);
    const int l15 = lane & 15, g = lane >> 4;
    for (int r0 = (bid * 4 + wave) * 4; r0 < NROW; r0 += G * 16) {
      const int row = r0 + g;
      const float* __restrict__ x = (l == 0) ? (row < PROW ? p.in[0] + (size_t)row * 1024 : p.in[1] + (size_t)(row - PROW) * 1024)
                                             : p.out + O_Y + (size_t)row * 1024;
      float4 v[16];
      float ss = 0.f;
#pragma unroll
      for (int i = 0; i < 16; ++i) v[i] = ntld4(x + (i * 16 + l15) * 4);
#pragma unroll
      for (int i = 0; i < 16; ++i) ss += v[i].x * v[i].x + v[i].y * v[i].y + v[i].z * v[i].z + v[i].w * v[i].w;
      ss = red16(ss);
      const float r = __builtin_amdgcn_rsqf(ss * (1.f / 1024.f) + EPSV);
#pragma unroll
      for (int i = 0; i < 16; ++i) {
        int c = (i * 16 + l15) * 4;
        float4 gg = *(const float4*)(ng + c);
        *(uint2*)(hbuf + (size_t)row * 1024 + c) = make_uint2(pack2(v[i].x * r * gg.x, v[i].y * r * gg.y), pack2(v[i].z * r * gg.z, v[i].w * r * gg.w));
      }
    }
  }
  const int gt = bid * 256 + tid, gn = G * 256;
  {
    const float* __restrict__ c_ckv = p.in[3] + (size_t)l * 32 * 1024 * 128;
    u16* __restrict__ ckv = (u16*)(ws + W_CKV);
#pragma unroll 4
    for (int i = gt; i < 32 * 1024 * 128 / 8; i += gn) {
      int e = i * 8, b = e >> 17, rem = e & 131071;
      const float4* s = (const float4*)(c_ckv + e);
      float4 a = ntld4((const float*)s), c = ntld4((const float*)s + 4);
      uint4 o = make_uint4(pack2(a.x, a.y), pack2(a.z, a.w), pack2(c.x, c.y), pack2(c.z, c.w));
      *(uint4*)(ckv + (size_t)(PROW + b * 1056) * 128 + rem) = o;
    }
    const float* __restrict__ c_kr = p.in[4] + (size_t)l * 32 * 1024 * 32;
    u16* __restrict__ kr = (u16*)(ws + W_KR);
    for (int i = gt; i < 32 * 1024 * 32 / 8; i += gn) {
      int e = i * 8, b = e >> 15, rem = e & 32767;
      const float4* s = (const float4*)(c_kr + e);
      float4 a = ntld4((const float*)s), c = ntld4((const float*)s + 4);
      uint4 o = make_uint4(pack2(a.x, a.y), pack2(a.z, a.w), pack2(c.x, c.y), pack2(c.z, c.w));
      *(uint4*)(kr + (size_t)(PROW + b * 1056) * 32 + rem) = o;
    }
    const float* __restrict__ c_bk = p.in[5] + (size_t)l * 32 * 512 * 256;
    u16* __restrict__ bk = (u16*)(ws + W_BK);
#pragma unroll 4
    for (int i = gt; i < 32 * 512 * 256 / 8; i += gn) {
      int e = i * 8, b = e >> 17, rem = e & 131071;
      const float4* s = (const float4*)(c_bk + e);
      float4 a = ntld4((const float*)s), c = ntld4((const float*)s + 4);
      uint4 o = make_uint4(pack2(a.x, a.y), pack2(a.z, a.w), pack2(c.x, c.y), pack2(c.z, c.w));
      *(uint4*)(bk + (size_t)(PROW + b * 544) * 256 + rem) = o;
    }
    const float* __restrict__ c_bv = p.in[6] + (size_t)l * 32 * 512 * 256;
    u16* __restrict__ bvt = (u16*)(ws + W_BVT);
#pragma unroll 4
    for (int i = gt; i < 32 * 128 * 256; i += gn) {
      int col = i & 255, j4 = (i >> 8) & 127, b = i >> 15;
      const float* s = c_bv + ((size_t)(b * 512 + j4 * 4)) * 256 + col;
      bf16x4 o = pack4(ntld1(s), ntld1(s + 256), ntld1(s + 512), ntld1(s + 768));
      *(bf16x4*)(bvt + band_t_addr(2 + b, j4 * 4, col >> 6, col & 63)) = o;
    }
    const float* __restrict__ st = p.in[2] + (size_t)l * 32 * 4 * 4096;
    u16* __restrict__ sst = (u16*)(ws + W_SST) + 1024ull * 4096;
#pragma unroll 4
    for (int i = gt; i < 128 * 4096; i += gn) {
      int d = i & 63, e = (i >> 6) & 63, bh = i >> 12;
      sst[i] = f2bf(ntld1(st + (size_t)bh * 4096 + d * 64 + e));
    }
  }
}

constexpr int TS = 136;
DI void stage_rm(u16* T, int wm, int wn, int g, int l15, int mt, int nt, int j, float v) {
  T[(wm * 64 + mt * 16 + g * 4 + j) * TS + wn * 64 + nt * 16 + l15] = f2bf(v);
}
DI void stage_tr(u16* T, int wm, int wn, int g, int l15, int mt, int nt, const f32x4& v) {
  *(bf16x4*)(T + (wn * 64 + nt * 16 + l15) * TS + wm * 64 + mt * 16 + g * 4) = pack4(v[0], v[1], v[2], v[3]);
}
template <int NROWS, int NCH, class F>
DI void tile_copy_out(const u16* T, int tid, F dst) {
#pragma unroll
  for (int i = 0; i < NROWS * NCH / 256; ++i) {
    int q = tid + i * 256, lr = q / NCH, cc = q % NCH;
    u16* d = dst(lr, cc);
    if (d) *(uint4*)d = *(const uint4*)(T + lr * TS + cc * 8);
  }
}

DI void phase1_epilogue(const Params& p, int l, f32x4 (&acc)[4][4], int m0, int n0, char* smem) {
  char* ws = p.ws;
  const int tid = otid(), lane = tid & 63, wave = tid >> 6;
  const int wm = wave >> 1, wn = wave & 1, l15 = lane & 15, g = lane >> 4;
  const int cb = n0 + wn * 64;
  const int rb = m0 + wm * 64;
  u16* T = (u16*)smem;
  __syncthreads();
  if (n0 < 512) {
    const bool isk = n0 >= 256;
    const int h = (cb & 255) >> 6;
    const float lg = gamma_lg2(h);
#pragma unroll
    for (int mt = 0; mt < 4; ++mt) {
#pragma unroll
      for (int j = 0; j < 4; ++j) {
        int row = rb + mt * 16 + g * 4 + j, seq, t, pos;
        row_info(row, seq, t, pos);
        float zeta = 1.f, sc = 1.f;
        if (isk) {
          sc = 0.125f;
          int e = row < PROW ? 63 - (t & 63) : 31 - t;
          zeta = ex2(lg * (float)e);
        }
#pragma unroll
        for (int nt = 0; nt < 2; ++nt) {
          int i = nt * 16 + l15;
          float c, s;
          rope_cs(pos, i, -LOG2_1E4 / 32.f, c, s);
          float x1 = acc[mt][nt][j] * sc, x2 = acc[mt][nt + 2][j] * sc;
          float o1 = x1 * c - x2 * s, o2 = x1 * s + x2 * c;
          stage_rm(T, wm, wn, g, l15, mt, nt, j, o1);
          stage_rm(T, wm, wn, g, l15, mt, nt + 2, j, o2);
          acc[mt][nt][j] = o1 * zeta;
          acc[mt][nt + 2][j] = o2 * zeta;
        }
      }
    }
    __syncthreads();
    {
      u16* dst = (u16*)(ws + (isk ? W_RETK : W_RETQ)) + (size_t)m0 * 256 + (n0 & 255);
      tile_copy_out<128, 16>(T, tid, [&](int lr, int cc) { return dst + (size_t)lr * 256 + cc * 8; });
    }
    if (isk) {
      __syncthreads();
#pragma unroll
      for (int mt = 0; mt < 4; ++mt)
#pragma unroll
        for (int nt = 0; nt < 4; ++nt) stage_tr(T, wm, wn, g, l15, mt, nt, acc[mt][nt]);
      __syncthreads();
      u16* kzt = (u16*)(ws + W_RETKZT);
      const int h0 = (n0 & 255) >> 6;
      tile_copy_out<128, 16>(T, tid, [&](int lr, int cc) {
        int seq, t, pos;
        row_info(m0 + cc * 8, seq, t, pos);
        return kzt + ret_t_addr(seq, t, h0 + (lr >> 6), lr & 63);
      });
    }
  } else if (n0 < 768) {
#pragma unroll
    for (int mt = 0; mt < 4; ++mt)
#pragma unroll
      for (int nt = 0; nt < 4; ++nt) stage_tr(T, wm, wn, g, l15, mt, nt, acc[mt][nt]);
    __syncthreads();
    u16* vt = (u16*)(ws + W_RETVT);
    const int h0 = (n0 - 512) >> 6;
    tile_copy_out<128, 16>(T, tid, [&](int lr, int cc) {
      int seq, t, pos;
      row_info(m0 + cc * 8, seq, t, pos);
      return vt + ret_t_addr(seq, t, h0 + (lr >> 6), lr & 63);
    });
  } else if (n0 < 1024 || (n0 >= 1408 && n0 < 1920) || (n0 >= 2688 && n0 < 2944)) {
    const int gc0 = n0 < 1024 ? n0 - 768 : (n0 < 1920 ? n0 - 1408 + 256 : n0 - 2688 + 768);
#pragma unroll
    for (int mt = 0; mt < 4; ++mt)
#pragma unroll
      for (int j = 0; j < 4; ++j)
#pragma unroll
        for (int nt = 0; nt < 4; ++nt) stage_rm(T, wm, wn, g, l15, mt, nt, j, silu(acc[mt][nt][j]));
    __syncthreads();
    u16* gate = (u16*)(ws + W_GATE) + (size_t)m0 * 1024 + gc0;
    tile_copy_out<128, 16>(T, tid, [&](int lr, int cc) { return gate + (size_t)lr * 1024 + cc * 8; });
  } else if (n0 < 1408 || n0 >= 2944) {
    const int zc0 = n0 < 1408 ? n0 - 1024 : 384;
#pragma unroll
    for (int mt = 0; mt < 4; ++mt)
#pragma unroll
      for (int j = 0; j < 4; ++j)
#pragma unroll
        for (int nt = 0; nt < 4; ++nt) stage_rm(T, wm, wn, g, l15, mt, nt, j, acc[mt][nt][j]);
    __syncthreads();
    u16* zr = (u16*)(ws + W_ZRAW) + (size_t)m0 * 416 + zc0;
    tile_copy_out<128, 16>(T, tid, [&](int lr, int cc) { return (zc0 + cc * 8 < 416) ? zr + (size_t)lr * 416 + cc * 8 : (u16*)nullptr; });
  } else if (n0 < 2432) {
    const bool isk = n0 >= 2176;
    const int h = ((cb - 1920) & 255) >> 6;
    const float* gn = p.in[isk ? 19 : 18] + l * 64;
    float gv[4];
#pragma unroll
    for (int nt = 0; nt < 4; ++nt) gv[nt] = gn[nt * 16 + l15];
#pragma unroll
    for (int mt = 0; mt < 4; ++mt)
#pragma unroll
      for (int j = 0; j < 4; ++j) {
        int row = rb + mt * 16 + g * 4 + j, seq, t, pos;
        row_info(row, seq, t, pos);
        float ss = 0.f;
#pragma unroll
        for (int nt = 0; nt < 4; ++nt) ss += acc[mt][nt][j] * acc[mt][nt][j];
        ss = red16(ss);
        float r = __builtin_amdgcn_rsqf(ss * (1.f / 64.f) + EPSV);
#pragma unroll
        for (int nt = 0; nt < 4; ++nt) {
          float o = acc[mt][nt][j] * r * gv[nt];
          stage_rm(T, wm, wn, g, l15, mt, nt, j, o);
          if (isk) {
            int c = h * 64 + nt * 16 + l15;
            if (seq < 2) { if (t >= 7680) p.out[O_PBK + ((size_t)(l * 2 + seq) * 512 + (t - 7680)) * 256 + c] = o; }
            else p.out[O_SBK + ((size_t)(l * 32 + seq - 2) * 32 + t) * 256 + c] = o;
          }
        }
      }
    __syncthreads();
    const int c0 = (n0 - 1920) & 255;
    if (!isk) {
      u16* bq = (u16*)(ws + W_BQ) + (size_t)m0 * 256 + c0;
      tile_copy_out<128, 16>(T, tid, [&](int lr, int cc) { return bq + (size_t)lr * 256 + cc * 8; });
    } else {
      u16* bk = (u16*)(ws + W_BK) + c0;
      tile_copy_out<128, 16>(T, tid, [&](int lr, int cc) {
        int seq, t, pos;
        row_info(m0 + lr, seq, t, pos);
        size_t brow = seq < 2 ? (size_t)(m0 + lr) : (size_t)(PROW + (seq - 2) * 544 + 512 + t);
        return bk + brow * 256 + cc * 8;
      });
    }
  } else {
    const int h = (cb - 2432) >> 6;
#pragma unroll
    for (int mt = 0; mt < 4; ++mt) {
      int row0 = rb + mt * 16 + g * 4, seq, t, pos;
      row_info(row0, seq, t, pos);
#pragma unroll
      for (int nt = 0; nt < 4; ++nt) {
        stage_tr(T, wm, wn, g, l15, mt, nt, acc[mt][nt]);
        int c = h * 64 + nt * 16 + l15;
#pragma unroll
        for (int j = 0; j < 4; ++j) {
          if (seq < 2) { if (t + j >= 7680) p.out[O_PBV + ((size_t)(l * 2 + seq) * 512 + (t + j - 7680)) * 256 + c] = acc[mt][nt][j]; }
          else p.out[O_SBV + ((size_t)(l * 32 + seq - 2) * 32 + t + j) * 256 + c] = acc[mt][nt][j];
        }
      }
    }
    __syncthreads();
    u16* bvt = (u16*)(ws + W_BVT);
    const int h0 = (n0 - 2432) >> 6;
    tile_copy_out<128, 16>(T, tid, [&](int lr, int cc) {
      int seq, t, pos;
      row_info(m0 + cc * 8, seq, t, pos);
      return bvt + band_t_addr(seq, seq < 2 ? t : 512 + t, h0 + (lr >> 6), lr & 63);
    });
  }
}

constexpr int VS = 72;
template <int DQ, int QT, bool BIAS, bool STATICM>
DI void attn_item(const u16* __restrict__ qptr, int qstride, int nq_valid,
                  const u16* __restrict__ k0ptr, int k0stride, const u16* __restrict__ k1ptr, int k1stride,
                  const u16* __restrict__ vtptr, int vtstride,
                  int kt_begin, int kt_end, int kv_len, int causal_chunk0,
                  float scale_l2, float mshift, const float* bias_s, int qpos0, int kpos0,
                  u16* mixp, char* smem, const u16* zsrc, bool store_en = true, int rot = 0) {
  constexpr int KS = DQ + 8;
  constexpr int NKC = DQ / 8;
  constexpr int NKL = 64 * NKC / 256;
  constexpr int STAGE = 64 * KS + 64 * VS;
  u16* S0 = (u16*)smem;
  const int tid = otid(), lane = tid & 63, wave = tid >> 6, l15 = lane & 15, g = lane >> 4;
  const int qrow_w = wave * 16 * QT;
  const bool active = qrow_w < nq_valid;
  int tile_end_w = kt_end;
  if (causal_chunk0 >= 0) { int e = causal_chunk0 + (qrow_w >> 6) + 1; tile_end_w = e < kt_end ? e : kt_end; }

  bf16x8 qf[QT][DQ / 32];
  if (active) {
#pragma unroll
    for (int qt = 0; qt < QT; ++qt)
#pragma unroll
      for (int ks = 0; ks < DQ / 32; ++ks)
        qf[qt][ks] = *(const bf16x8*)(qptr + (size_t)(qrow_w + qt * 16 + l15) * qstride + ks * 32 + g * 8);
  } else {
#pragma unroll
    for (int qt = 0; qt < QT; ++qt)
#pragma unroll
      for (int ks = 0; ks < DQ / 32; ++ks) qf[qt][ks] = bf16x8{0, 0, 0, 0, 0, 0, 0, 0};
  }
  f32x4 o[4][QT];
  float mrow[QT], lsum[QT];
#pragma unroll
  for (int qt = 0; qt < QT; ++qt) {
    mrow[qt] = -1e30f; lsum[qt] = 0.f;
#pragma unroll
    for (int dvt = 0; dvt < 4; ++dvt) o[dvt][qt] = f32x4{0.f, 0.f, 0.f, 0.f};
  }
  uint4 pk0, pk1, pk2, pv0, pv1;
  pk2 = make_uint4(0, 0, 0, 0);
#define AKPTR(i) const u16* kp##i; int kstep##i, kkey##i; { int c = tid + i * 256, key = c / NKC, part = c % NKC; kkey##i = key; \
    const bool rp = (DQ == 96) && part >= 8; \
    kp##i = rp ? k1ptr + (size_t)key * k1stride + (part - 8) * 8 : k0ptr + (size_t)key * k0stride + part * 8; \
    kstep##i = (rp ? k1stride : k0stride) * 64; }
  AKPTR(0) AKPTR(1) AKPTR(2)
  const int vdv0 = tid >> 3, vkc = (tid & 7) * 8;
  const u16* vp0 = vtptr + (size_t)vdv0 * vtstride + vkc;
  const u16* vp1 = vtptr + (size_t)(vdv0 + 32) * vtstride + vkc;
#define AKLD(S, i, tile) { const u16* a_ = kp##i + (size_t)(tile) * kstep##i; if ((tile) * 64 + kkey##i >= kv_len) a_ = zsrc; S##k##i = *(const uint4*)a_; }
#define AVLD(S, i, tile) { const u16* a_ = vp##i + (tile) * 64; if ((tile) * 64 + vkc >= kv_len) a_ = zsrc; S##v##i = *(const uint4*)a_; }
#define AKST(S, i, st) { int c = tid + i * 256, key = c / NKC, part = c % NKC; *(uint4*)((st) + key * KS + part * 8) = S##k##i; }
#define AVST(S, i, st) { int c = tid + i * 256, dv = c >> 3, kc = c & 7; *(uint4*)((st) + 64 * KS + dv * VS + kc * 8) = S##v##i; }
#define AGLOAD(S, tile) { AKLD(S, 0, tile) AKLD(S, 1, tile) if (NKL > 2) AKLD(S, 2, tile) AVLD(S, 0, tile) AVLD(S, 1, tile) }
#define ALSTORE(S, st) { AKST(S, 0, st) AKST(S, 1, st) if (NKL > 2) AKST(S, 2, st) AVST(S, 0, st) AVST(S, 1, st) }
  auto compute = [&](const int tile, const u16* Ks) {
    const u16* Vs = Ks + 64 * KS;
    if (active && tile < tile_end_w) {
      f32x4 s[4][QT];
#pragma unroll
      for (int kt = 0; kt < 4; ++kt)
#pragma unroll
        for (int qt = 0; qt < QT; ++qt) s[kt][qt] = f32x4{0.f, 0.f, 0.f, 0.f};
      {
        bf16x8 kf[4], kn[4];
#pragma unroll
        for (int kt = 0; kt < 4; ++kt) kf[kt] = *(const bf16x8*)(Ks + (kt * 16 + l15) * KS + g * 8);
#pragma unroll
        for (int ks = 0; ks < DQ / 32; ++ks) {
          if (ks + 1 < DQ / 32) {
#pragma unroll
            for (int kt = 0; kt < 4; ++kt) kn[kt] = *(const bf16x8*)(Ks + (kt * 16 + l15) * KS + (ks + 1) * 32 + g * 8);
          }
#pragma unroll
          for (int kt = 0; kt < 4; ++kt)
#pragma unroll
            for (int qt = 0; qt < QT; ++qt) s[kt][qt] = MFMA(kf[kt], qf[qt][ks], s[kt][qt]);
          if (ks + 1 < DQ / 32) {
#pragma unroll
            for (int kt = 0; kt < 4; ++kt) kf[kt] = kn[kt];
          }
        }
      }
      if (STATICM) {
#pragma unroll
        for (int qt = 0; qt < QT; ++qt) {
          float ps = 0.f;
#pragma unroll
          for (int kt = 0; kt < 4; ++kt)
#pragma unroll
            for (int j = 0; j < 4; ++j) {
              float pe = ex2(fmaf(s[kt][qt][j], scale_l2, -mshift));
              s[kt][qt][j] = pe;
              ps += pe;
            }
          lsum[qt] += ps;
        }
      } else {
        const bool partial = tile * 64 + 64 > kv_len;
        bool farbias = false;
        if (BIAS) farbias = (qpos0 - (kpos0 + tile * 64 + 63)) >= 128;
#pragma unroll
        for (int qt = 0; qt < QT; ++qt) {
          float mx = -1e30f;
          const int qp = qpos0 + qrow_w + qt * 16 + l15;
#pragma unroll
          for (int kt = 0; kt < 4; ++kt)
#pragma unroll
            for (int j = 0; j < 4; ++j) {
              int key = tile * 64 + kt * 16 + g * 4 + j;
              float v = s[kt][qt][j] * scale_l2;
              if (BIAS) {
                if (farbias) v += bias_s[256];
                else {
                  int d = qp - (kpos0 + key);
                  d = d < -128 ? -128 : (d > 128 ? 128 : d);
                  v += bias_s[d + 128];
                }
              }
              if (partial && key >= kv_len) v = -1e30f;
              s[kt][qt][j] = v;
              mx = fmaxf(mx, v);
            }
          mx = fmaxf(mx, __shfl_xor(mx, 16));
          mx = fmaxf(mx, __shfl_xor(mx, 32));
          float mn = fmaxf(mrow[qt], mx);
          float alpha = ex2(mrow[qt] - mn);
          mrow[qt] = mn;
          float ps = 0.f;
#pragma unroll
          for (int kt = 0; kt < 4; ++kt)
#pragma unroll
            for (int j = 0; j < 4; ++j) {
              float pe = ex2(s[kt][qt][j] - mn);
              s[kt][qt][j] = pe;
              ps += pe;
            }
          lsum[qt] = lsum[qt] * alpha + ps;
#pragma unroll
          for (int dvt = 0; dvt < 4; ++dvt) o[dvt][qt] *= alpha;
        }
      }
#pragma unroll
      for (int si = 0; si < 2; ++si) {
        bf16x8 pf[QT];
#pragma unroll
        for (int qt = 0; qt < QT; ++qt) {
          uint4 u = make_uint4(pack2(s[2 * si][qt][0], s[2 * si][qt][1]), pack2(s[2 * si][qt][2], s[2 * si][qt][3]),
                               pack2(s[2 * si + 1][qt][0], s[2 * si + 1][qt][1]), pack2(s[2 * si + 1][qt][2], s[2 * si + 1][qt][3]));
          pf[qt] = __builtin_bit_cast(bf16x8, u);
        }
        bf16x8 vf[4];
#pragma unroll
        for (int dvt = 0; dvt < 4; ++dvt) {
          bf16x4 lo = *(const bf16x4*)(Vs + (dvt * 16 + l15) * VS + si * 32 + g * 4);
          bf16x4 hi = *(const bf16x4*)(Vs + (dvt * 16 + l15) * VS + si * 32 + 16 + g * 4);
          vf[dvt] = __builtin_shufflevector(lo, hi, 0, 1, 2, 3, 4, 5, 6, 7);
        }
#pragma unroll
        for (int dvt = 0; dvt < 4; ++dvt)
#pragma unroll
          for (int qt = 0; qt < QT; ++qt) o[dvt][qt] = MFMA(vf[dvt], pf[qt], o[dvt][qt]);
      }
    }
  };
  u16* S1 = S0 + STAGE;
  const int ntile = kt_end - kt_begin;
  int tcur = kt_begin + rot;
#define TNEXT(t) (((t) + 1 == kt_end) ? kt_begin : (t) + 1)
  int t1 = TNEXT(tcur);
  AGLOAD(p, tcur)
  ALSTORE(p, S0)
  AGLOAD(p, t1)
  for (int i = 0; i < ntile; i += 2) {
    __syncthreads();
    const int t2 = TNEXT(t1);
    ALSTORE(p, S1)
    AGLOAD(p, t2)
    compute(tcur, S0);
    if (i + 1 >= ntile) break;
    __syncthreads();
    const int t3 = TNEXT(t2);
    ALSTORE(p, S0)
    AGLOAD(p, t3)
    compute(t1, S1);
    tcur = t2; t1 = t3;
  }
  if (active && store_en) {
#pragma unroll
    for (int qt = 0; qt < QT; ++qt) {
      float lt = redg(lsum[qt]);
      float inv = 1.f / lt;
      u16* mp = mixp + (size_t)(qrow_w + qt * 16 + l15) * 1024;
#pragma unroll
      for (int dvt = 0; dvt < 4; ++dvt) {
        u16* a = mp + dvt * 16 + g * 4;
        bf16x4 gt4 = *(const bf16x4*)a;
        *(bf16x4*)a = pack4(o[dvt][qt][0] * inv * bf2f((u16)gt4[0]), o[dvt][qt][1] * inv * bf2f((u16)gt4[1]),
                            o[dvt][qt][2] * inv * bf2f((u16)gt4[2]), o[dvt][qt][3] * inv * bf2f((u16)gt4[3]));
      }
    }
  }
}

DI void p2_norm_rows4(const Params& p, int l, int rbase) {
  char* ws = p.ws;
  const int lane = otid() & 63, l15 = lane & 15, g = lane >> 4;
  const int row = rbase + g;
  const u16* z = (const u16*)(ws + W_ZRAW) + (size_t)row * 416;
  int seq, t, pos;
  row_info(row, seq, t, pos);
  const size_t kvrow = seq < 2 ? (size_t)row : (size_t)(PROW + (seq - 2) * 1056 + 1024 + t);
  const uint4 zc0 = *(const uint4*)(z + l15 * 16), zc1 = *(const uint4*)(z + l15 * 16 + 8);
  const uint4 zk = *(const uint4*)(z + 256 + l15 * 8);
  const float ka = bf2f(z[384 + l15]), kb = bf2f(z[400 + l15]);
  {
    const unsigned w[8] = {zc0.x, zc0.y, zc0.z, zc0.w, zc1.x, zc1.y, zc1.z, zc1.w};
    float v[16];
    float ss = 0.f;
#pragma unroll
    for (int i = 0; i < 8; ++i) { v[2 * i] = bf2f((u16)(w[i] & 0xffff)); v[2 * i + 1] = bf2f((u16)(w[i] >> 16)); ss += v[2 * i] * v[2 * i] + v[2 * i + 1] * v[2 * i + 1]; }
    ss = red16(ss);
    const float r = __builtin_amdgcn_rsqf(ss * (1.f / 256.f) + EPSV);
    const float* gp = p.in[10] + l * 256 + l15 * 16;
    unsigned o[8];
#pragma unroll
    for (int i = 0; i < 4; ++i) {
      float4 gg = *(const float4*)(gp + i * 4);
      o[2 * i] = pack2(v[4 * i] * r * gg.x, v[4 * i + 1] * r * gg.y);
      o[2 * i + 1] = pack2(v[4 * i + 2] * r * gg.z, v[4 * i + 3] * r * gg.w);
    }
    u16* d = (u16*)(ws + W_CQ) + (size_t)row * 256 + l15 * 16;
    *(uint4*)d = make_uint4(o[0], o[1], o[2], o[3]);
    *(uint4*)(d + 8) = make_uint4(o[4], o[5], o[6], o[7]);
  }
  {
    const unsigned w[4] = {zk.x, zk.y, zk.z, zk.w};
    float v[8];
    float ss = 0.f;
#pragma unroll
    for (int i = 0; i < 4; ++i) { v[2 * i] = bf2f((u16)(w[i] & 0xffff)); v[2 * i + 1] = bf2f((u16)(w[i] >> 16)); ss += v[2 * i] * v[2 * i] + v[2 * i + 1] * v[2 * i + 1]; }
    ss = red16(ss);
    const float r = __builtin_amdgcn_rsqf(ss * (1.f / 128.f) + EPSV);
    const float* gp = p.in[14] + l * 128 + l15 * 8;
    const float4 g0 = *(const float4*)gp, g1 = *(const float4*)(gp + 4);
    const float o0 = v[0] * r * g0.x, o1 = v[1] * r * g0.y, o2 = v[2] * r * g0.z, o3 = v[3] * r * g0.w;
    const float o4 = v[4] * r * g1.x, o5 = v[5] * r * g1.y, o6 = v[6] * r * g1.z, o7 = v[7] * r * g1.w;
    *(uint4*)((u16*)(ws + W_CKV) + kvrow * 128 + l15 * 8) = make_uint4(pack2(o0, o1), pack2(o2, o3), pack2(o4, o5), pack2(o6, o7));
    float* dst = (seq < 2 ? p.out + O_PCKV + ((size_t)(l * 2 + seq) * 8192 + t) * 128 : p.out + O_SCKV + ((size_t)(l * 32 + seq - 2) * 32 + t) * 128) + l15 * 8;
    ntst4(dst, make_float4(o0, o1, o2, o3));
    ntst4(dst + 4, make_float4(o4, o5, o6, o7));
  }
  {
    const float ss = red16(ka * ka + kb * kb);
    const float r = __builtin_amdgcn_rsqf(ss * (1.f / 32.f) + EPSV);
    const float y1 = ka * r * p.in[15][l * 32 + l15], y2 = kb * r * p.in[15][l * 32 + 16 + l15];
    float c, sn;
    rope_cs(pos, l15, -LOG2_1E4 / 16.f, c, sn);
    const float o1 = y1 * c - y2 * sn, o2 = y1 * sn + y2 * c;
    u16* kd = (u16*)(ws + W_KR) + kvrow * 32;
    kd[l15] = f2bf(o1);
    kd[16 + l15] = f2bf(o2);
    float* dst = seq < 2 ? p.out + O_PKR + ((size_t)(l * 2 + seq) * 8192 + t) * 32 : p.out + O_SKR + ((size_t)(l * 32 + seq - 2) * 32 + t) * 32;
    dst[l15] = o1;
    dst[16 + l15] = o2;
  }
}

DI void p2_kvc(const Params& p, int idx) {
  char* ws = p.ws;
  const int lane = otid() & 63, l15 = lane & 15, g = lane >> 4;
  const u16* vt = (const u16*)(ws + W_RETVT);
  const u16* kz = (const u16*)(ws + W_RETKZT);
  size_t base; int stride, nks;
  if (idx < 1024) { int sh = idx >> 7, c = idx & 127; base = (size_t)sh * 64 * 8192 + c * 64; stride = 8192; nks = 2; }
  else { base = 4194304ull + (size_t)(idx - 1024) * 64 * 32; stride = 32; nks = 1; }
  f32x4 acc[4][4];
#pragma unroll
  for (int mt = 0; mt < 4; ++mt)
#pragma unroll
    for (int nt = 0; nt < 4; ++nt) acc[mt][nt] = f32x4{0.f, 0.f, 0.f, 0.f};
  for (int ks = 0; ks < nks; ++ks) {
    bf16x8 af[4], bfr[4];
#pragma unroll
    for (int mt = 0; mt < 4; ++mt) af[mt] = *(const bf16x8*)(vt + base + (size_t)(mt * 16 + l15) * stride + ks * 32 + g * 8);
#pragma unroll
    for (int nt = 0; nt < 4; ++nt) bfr[nt] = *(const bf16x8*)(kz + base + (size_t)(nt * 16 + l15) * stride + ks * 32 + g * 8);
#pragma unroll
    for (int mt = 0; mt < 4; ++mt)
#pragma unroll
      for (int nt = 0; nt < 4; ++nt) acc[mt][nt] = MFMA(af[mt], bfr[nt], acc[mt][nt]);
  }
  float* dst = (float*)(ws + W_KVC) + (size_t)idx * 4096;
#pragma unroll
  for (int mt = 0; mt < 4; ++mt)
#pragma unroll
    for (int nt = 0; nt < 4; ++nt)
#pragma unroll
      for (int j = 0; j < 4; ++j) dst[(mt * 16 + g * 4 + j) * 64 + nt * 16 + l15] = acc[mt][nt][j];
}

DI void phase2(const Params& p, int l, char* smem, int* ctr, int* s_item, int xcd, bool store_en = true) {
  char* ws = p.ws;
  const int tid = otid(), wave = __builtin_amdgcn_readfirstlane(tid >> 6);
  float* bias_s = (float*)(smem + 2 * (64 * 72 + 64 * VS) * 2);
  constexpr int N_BP = 128, N_BS = 16, N_KVC = 36, N_NORM = 68;
  constexpr int N_ALL = N_BP + N_BS + N_KVC + N_NORM;
  for (int qi = 0; qi < 8; ++qi) {
    const int xq = (xcd + qi) & 7;
    for (;;) {
      __syncthreads();
      if (tid == 0) *s_item = atomicAdd(ctr + xq * 32, 1);
      __syncthreads();
      const int it = __builtin_amdgcn_readfirstlane(*s_item);
      if (it >= N_ALL) break;
      if (it < N_BP + N_BS) {
        int seq, h, qrow0, nq, ktb, kte, kvlen, qpos0, kpos0;
        size_t kbase;
        if (it < N_BP) {
          int c = 127 - it, sh = xq;
          seq = sh >> 2; h = sh & 3;
          qrow0 = seq * 8192 + c * 64; nq = 64;
          ktb = c - 8 < 0 ? 0 : c - 8; kte = c + 1; kvlen = 8192;
          qpos0 = c * 64; kpos0 = 0;
          kbase = (size_t)seq * 8192;
        } else {
          int j = xq * 16 + (it - N_BP);
          seq = 2 + (j >> 2); h = j & 3;
          qrow0 = PROW + (seq - 2) * 32; nq = 32;
          ktb = 0; kte = 9; kvlen = 544;
          qpos0 = 1024; kpos0 = 512;
          kbase = (size_t)PROW + (size_t)(seq - 2) * 544;
        }
        const float* bb = p.in[20] + (size_t)(l * 4 + h) * 257;
        for (int i = tid; i < 257; i += 256) bias_s[i] = bb[i] * LOG2E;
        const u16* bq = (const u16*)(ws + W_BQ) + (size_t)qrow0 * 256 + h * 64;
        const u16* bk = (const u16*)(ws + W_BK) + kbase * 256 + h * 64;
        const u16* bvt = (const u16*)(ws + W_BVT) + band_t_addr(seq, 0, h, 0);
        u16* mix = (u16*)(ws + W_GATE) + (size_t)qrow0 * 1024 + 768 + h * 64;
        attn_item<64, 1, true, false>(bq, 256, nq, bk, 256, nullptr, 0, bvt, seq < 2 ? 8192 : 544, ktb, kte, kvlen, -1,
                                      0.125f * LOG2E, 0.f, bias_s, qpos0, kpos0, mix, smem, (const u16*)(ws + W_CTR + 3968), store_en);
      } else if (it < N_BP + N_BS + N_KVC) {
        p2_kvc(p, (xq * N_KVC + it - N_BP - N_BS) * 4 + wave);
      } else {
        int r0 = (xq * N_NORM + it - N_BP - N_BS - N_KVC) * 32 + wave * 8;
        p2_norm_rows4(p, l, r0);
        p2_norm_rows4(p, l, r0 + 4);
      }
    }
  }
}

DI void phase3(const Params& p, int l, char* smem, int* ctr, int* s_item, int xcd) {
  char* ws = p.ws;
  const int G = gridDim.x, bid = blockIdx.x, tid = otid();
  const int lane = tid & 63, wave = tid >> 6, wm = wave >> 1, wn = wave & 1, l15 = lane & 15, g = lane >> 4;
  for (int it = bid; it < 256; it += G) {
    const float* __restrict__ kvc = (const float*)(ws + W_KVC);
    if (it < 128) {
      int sh = it >> 4, el = (it & 15) * 256 + tid, h = sh & 3;
      float g64 = ex2(gamma_lg2(h) * 64.f);
      u16* __restrict__ sst = (u16*)(ws + W_SST);
      float S = 0.f;
      for (int c0 = 0; c0 < 128; c0 += 16) {
        float kv[16];
#pragma unroll
        for (int j = 0; j < 16; ++j) kv[j] = kvc[(size_t)(sh * 128 + c0 + j) * 4096 + el];
#pragma unroll
        for (int j = 0; j < 16; ++j) {
          sst[(size_t)(sh * 128 + c0 + j) * 4096 + el] = f2bf(S);
          S = g64 * S + kv[j];
        }
      }
      int e = el >> 6, d = el & 63;
      p.out[O_PSTATE + (size_t)(l * 8 + sh) * 4096 + d * 64 + e] = S;
    } else {
      int bh = it - 128, h = bh & 3;
      float g32 = ex2(gamma_lg2(h) * 32.f);
      const float* __restrict__ sin_ = p.in[2] + (size_t)(l * 128 + bh) * 4096;
      float a0[16], a1[16];
#pragma unroll
      for (int i = 0; i < 16; ++i) {
        int el = i * 256 + tid, d = el >> 6, e = el & 63;
        a0[i] = sin_[el];
        a1[i] = kvc[(size_t)(1024 + bh) * 4096 + e * 64 + d];
      }
#pragma unroll
      for (int i = 0; i < 16; ++i) p.out[O_SSTATE + (size_t)(l * 128 + bh) * 4096 + i * 256 + tid] = g32 * a0[i] + a1[i];
    }
  }
  gemm_tiles_dyn(ctr, s_item, xcd, 392, 8, [&](int mp, int n) {
    f32x4 acc[4][4];
    gemm_core((const u16*)(ws + W_CKV), 128, (const u16*)(ws + W_WUKV), 128, 128, mp * 128, n * 128, acc, smem);
    const int rb = mp * 128 + wm * 64, h = n, m0 = mp * 128;
    u16* T = (u16*)smem;
    u16* T2 = T + 128 * TS;
    __syncthreads();
    if (wn == 0) {
      const float* gn = p.in[17] + l * 64;
      float gv[4];
#pragma unroll
      for (int nt = 0; nt < 4; ++nt) gv[nt] = gn[nt * 16 + l15];
#pragma unroll
      for (int mt = 0; mt < 4; ++mt)
#pragma unroll
        for (int j = 0; j < 4; ++j) {
          float ss = 0.f;
#pragma unroll
          for (int nt = 0; nt < 4; ++nt) ss += acc[mt][nt][j] * acc[mt][nt][j];
          ss = red16(ss);
          float r = __builtin_amdgcn_rsqf(ss * (1.f / 64.f) + EPSV);
#pragma unroll
          for (int nt = 0; nt < 4; ++nt) stage_rm(T, wm, 0, g, l15, mt, nt, j, acc[mt][nt][j] * r * gv[nt]);
        }
    } else {
#pragma unroll
      for (int mt = 0; mt < 4; ++mt)
#pragma unroll
        for (int nt = 0; nt < 4; ++nt) stage_tr(T2, wm, 0, g, l15, mt, nt, acc[mt][nt]);
    }
    (void)rb;
    __syncthreads();
    {
      u16* kn = (u16*)(ws + W_KNOPE) + (size_t)m0 * 512 + h * 64;
      tile_copy_out<128, 8>(T, tid, [&](int lr, int cc) { return kn + (size_t)lr * 512 + cc * 8; });
      u16* vt = (u16*)(ws + W_VT);
      tile_copy_out<64, 16>(T2, tid, [&](int lr, int cc) {
        int row = m0 + cc * 8, seq, tk;
        if (row < PROW) { seq = row >> 13; tk = row & 8191; }
        else { int r = row - PROW; int s2 = r / 1056; seq = 2 + s2; tk = r - s2 * 1056; }
        return vt + mla_t_addr(seq, tk, h, lr);
      });
    }
  });
  gemm_tiles_dyn(ctr + 1, s_item, xcd, 136, 6, [&](int mp, int n) {
    f32x4 acc[4][4];
    gemm_core((const u16*)(ws + W_CQ), 256, (const u16*)(ws + W_WUQ), 256, 256, mp * 128, n * 128, acc, smem);
    const int rb = mp * 128 + wm * 64, m0 = mp * 128;
    u16* qm = (u16*)(ws + W_H) + (size_t)m0 * 768;
    u16* T = (u16*)smem;
    __syncthreads();
    if (n < 4) {
      const float* gn = p.in[12] + l * 64;
      float gv[4];
#pragma unroll
      for (int nt = 0; nt < 4; ++nt) gv[nt] = gn[nt * 16 + l15];
#pragma unroll
      for (int mt = 0; mt < 4; ++mt)
#pragma unroll
        for (int j = 0; j < 4; ++j) {
          float ss = 0.f;
#pragma unroll
          for (int nt = 0; nt < 4; ++nt) ss += acc[mt][nt][j] * acc[mt][nt][j];
          ss = red16(ss);
          float r = __builtin_amdgcn_rsqf(ss * (1.f / 64.f) + EPSV);
#pragma unroll
          for (int nt = 0; nt < 4; ++nt) stage_rm(T, wm, wn, g, l15, mt, nt, j, acc[mt][nt][j] * r * gv[nt]);
        }
      __syncthreads();
      tile_copy_out<128, 16>(T, tid, [&](int lr, int cc) { return qm + (size_t)lr * 768 + (2 * n + (cc >> 3)) * 96 + (cc & 7) * 8; });
    } else {
      const float* gn = p.in[13] + l * 32;
      const float g0 = gn[l15], g1 = gn[16 + l15];
#pragma unroll
      for (int mt = 0; mt < 4; ++mt)
#pragma unroll
        for (int j = 0; j < 4; ++j) {
          int row = rb + mt * 16 + g * 4 + j, seq, t, pos;
          row_info(row, seq, t, pos);
          float c, sn;
          rope_cs(pos, l15, -LOG2_1E4 / 16.f, c, sn);
#pragma unroll
          for (int hp = 0; hp < 2; ++hp) {
            float a0 = acc[mt][2 * hp][j], a1 = acc[mt][2 * hp + 1][j];
            float ss = red16(a0 * a0 + a1 * a1);
            float r = __builtin_amdgcn_rsqf(ss * (1.f / 32.f) + EPSV);
            float x1 = a0 * r * g0, x2 = a1 * r * g1;
            u16* tp = T + (wm * 64 + mt * 16 + g * 4 + j) * TS + wn * 64 + hp * 32 + l15;
            tp[0] = f2bf(x1 * c - x2 * sn);
            tp[16] = f2bf(x1 * sn + x2 * c);
          }
        }
      __syncthreads();
      const int hb = (n * 128 - 512) >> 5;
      tile_copy_out<128, 16>(T, tid, [&](int lr, int cc) { return qm + (size_t)lr * 768 + (hb + (cc >> 2)) * 96 + 64 + (cc & 3) * 8; });
    }
  });
}

DI void p4_ret(const Params& p, int l, int idx, int qt, bool store_en = true) {
  char* ws = p.ws;
  const int lane = otid() & 63, l15 = lane & 15, g = lane >> 4;
  int seq, h, row0, L, stride;
  size_t tbase;
  if (idx < 1024) { int sh = idx >> 7, c = idx & 127; seq = sh >> 2; h = sh & 3; row0 = seq * 8192 + c * 64; L = 64; stride = 8192; tbase = (size_t)sh * 64 * 8192 + c * 64; }
  else { int j = idx - 1024; seq = 2 + (j >> 2); h = j & 3; row0 = PROW + (seq - 2) * 32; L = 32; stride = 32; tbase = 4194304ull + (size_t)j * 64 * 32; }
  const float lg = gamma_lg2(h);
  const u16* rq = (const u16*)(ws + W_RETQ);
  const u16* rk = (const u16*)(ws + W_RETK);
  const u16* vt = (const u16*)(ws + W_RETVT) + tbase;
  const u16* sst = (const u16*)(ws + W_SST) + (size_t)idx * 4096;
  bf16x8 qf[2];
#pragma unroll
  for (int ks = 0; ks < 2; ++ks) qf[ks] = *(const bf16x8*)(rq + (size_t)(row0 + qt * 16 + l15) * 256 + h * 64 + ks * 32 + g * 8);
  f32x4 st[4];
#pragma unroll
  for (int kt = 0; kt < 4; ++kt) st[kt] = f32x4{0.f, 0.f, 0.f, 0.f};
  const int lq = qt * 16 + l15;
#pragma unroll
  for (int kt = 0; kt < 4; ++kt) {
    if (kt <= qt) {
#pragma unroll
      for (int ks = 0; ks < 2; ++ks) {
        bf16x8 kf = *(const bf16x8*)(rk + (size_t)(row0 + kt * 16 + l15) * 256 + h * 64 + ks * 32 + g * 8);
        st[kt] = MFMA(kf, qf[ks], st[kt]);
      }
#pragma unroll
      for (int j = 0; j < 4; ++j) {
        int m = kt * 16 + g * 4 + j;
        st[kt][j] = lq >= m ? st[kt][j] * ex2(lg * (float)(lq - m)) : 0.f;
      }
    }
  }
  f32x4 o[4], o2[4];
#pragma unroll
  for (int et = 0; et < 4; ++et) { o[et] = f32x4{0.f, 0.f, 0.f, 0.f}; o2[et] = f32x4{0.f, 0.f, 0.f, 0.f}; }
#pragma unroll
  for (int si = 0; si < 2; ++si) {
    if (2 * si <= qt && si * 32 < L) {
      uint4 u = make_uint4(pack2(st[2 * si][0], st[2 * si][1]), pack2(st[2 * si][2], st[2 * si][3]),
                           pack2(st[2 * si + 1][0], st[2 * si + 1][1]), pack2(st[2 * si + 1][2], st[2 * si + 1][3]));
      bf16x8 pf = __builtin_bit_cast(bf16x8, u);
#pragma unroll
      for (int et = 0; et < 4; ++et) {
        bf16x4 lo = *(const bf16x4*)(vt + (size_t)(et * 16 + l15) * stride + si * 32 + g * 4);
        bf16x4 hi = *(const bf16x4*)(vt + (size_t)(et * 16 + l15) * stride + si * 32 + 16 + g * 4);
        bf16x8 vf = __builtin_shufflevector(lo, hi, 0, 1, 2, 3, 4, 5, 6, 7);
        o[et] = MFMA(vf, pf, o[et]);
      }
    }
  }
#pragma unroll
  for (int et = 0; et < 4; ++et)
#pragma unroll
    for (int ks = 0; ks < 2; ++ks) {
      bf16x8 sf = *(const bf16x8*)(sst + (et * 16 + l15) * 64 + ks * 32 + g * 8);
      o2[et] = MFMA(sf, qf[ks], o2[et]);
    }
  const float xi = ex2(lg * (float)(lq + 1));
  float ss = 0.f;
#pragma unroll
  for (int et = 0; et < 4; ++et)
#pragma unroll
    for (int j = 0; j < 4; ++j) { float v = o[et][j] + o2[et][j] * xi; o[et][j] = v; ss += v * v; }
  ss = redg(ss);
  const float r = __builtin_amdgcn_rsqf(ss * (1.f / 64.f) + EPSV);
  const float* gn = p.in[9] + l * 256 + h * 64;
  u16* mp = (u16*)(ws + W_GATE) + (size_t)(row0 + lq) * 1024 + h * 64;
  if (store_en)
#pragma unroll
  for (int et = 0; et < 4; ++et) {
    u16* a = mp + et * 16 + g * 4;
    float4 gg = *(const float4*)(gn + et * 16 + g * 4);
    bf16x4 gt4 = *(const bf16x4*)a;
    *(bf16x4*)a = pack4(o[et][0] * r * gg.x * bf2f((u16)gt4[0]), o[et][1] * r * gg.y * bf2f((u16)gt4[1]),
                        o[et][2] * r * gg.z * bf2f((u16)gt4[2]), o[et][3] * r * gg.w * bf2f((u16)gt4[3]));
  }
}

DI void phase4(const Params& p, int l, char* smem, int* ctr, int* s_item, int xcd, bool store_en = true) {
  char* ws = p.ws;
  const int tid = otid(), wave = __builtin_amdgcn_readfirstlane(tid >> 6), lane = tid & 63;
  constexpr int N_MP = 128, N_MS = 32, N_RP = 128, N_RS = 8;
  constexpr int N_ALL = N_MP + N_MS + N_RP + N_RS;
  const float sc = 0.10206207261596575f * LOG2E;
  float mshift;
  {
    float a = fabsf(p.in[12][l * 64 + lane]), b = fabsf(p.in[13][l * 32 + (lane & 31)]);
    float c = fabsf(p.in[17][l * 64 + lane]), d = fabsf(p.in[15][l * 32 + (lane & 31)]);
#pragma unroll
    for (int o = 32; o; o >>= 1) {
      a = fmaxf(a, __shfl_xor(a, o)); b = fmaxf(b, __shfl_xor(b, o));
      c = fmaxf(c, __shfl_xor(c, o)); d = fmaxf(d, __shfl_xor(d, o));
    }
    mshift = sc * 1.02f * sqrtf((64.f * a * a + 32.f * b * b) * (64.f * c * c + 32.f * d * d));
  }
  for (int qi = 0; qi < 8; ++qi) {
    const int xq = (xcd + qi) & 7;
    for (;;) {
      __syncthreads();
      if (tid == 0) *s_item = atomicAdd(ctr + xq * 32, 1);
      __syncthreads();
      const int it = __builtin_amdgcn_readfirstlane(*s_item);
      if (it >= N_ALL) break;
      if (it < N_MP) {
        const int ip = it;
        int qb = 63 - (ip >> 1), sh = xq * 2 + (ip & 1);
        int seq = sh >> 3, h = sh & 7;
        int qrow0 = seq * 8192 + qb * 128;
        size_t kb = (size_t)seq * 8192;
        const u16* q = (const u16*)(ws + W_H) + (size_t)qrow0 * 768 + h * 96;
        const u16* kn = (const u16*)(ws + W_KNOPE) + kb * 512 + h * 64;
        const u16* kr = (const u16*)(ws + W_KR) + kb * 32;
        const u16* vt = (const u16*)(ws + W_VT) + mla_t_addr(seq, 0, h, 0);
        u16* mix = (u16*)(ws + W_GATE) + (size_t)qrow0 * 1024 + 256 + h * 64;
        attn_item<96, 2, false, true>(q, 768, 128, kn, 512, kr, 32, vt, 8192, 0, qb * 2 + 2, 8192, qb * 2, sc, mshift, nullptr, 0, 0, mix, smem, (const u16*)(ws + W_CTR + 3968), store_en,
                                      (int)((unsigned)(qb * 29 + 7) % (unsigned)(qb * 2 + 2)));
      } else if (it < N_MP + N_MS) {
        int j = xq * N_MS + it - N_MP, b = j >> 3, h = j & 7, seq = 2 + b;
        int qrow0 = PROW + b * 32;
        size_t kb = (size_t)PROW + (size_t)b * 1056;
        const u16* q = (const u16*)(ws + W_H) + (size_t)qrow0 * 768 + h * 96;
        const u16* kn = (const u16*)(ws + W_KNOPE) + kb * 512 + h * 64;
        const u16* kr = (const u16*)(ws + W_KR) + kb * 32;
        const u16* vt = (const u16*)(ws + W_VT) + mla_t_addr(seq, 0, h, 0);
        u16* mix = (u16*)(ws + W_GATE) + (size_t)qrow0 * 1024 + 256 + h * 64;
        attn_item<96, 1, false, false>(q, 768, 32, kn, 512, kr, 32, vt, 1056, 0, 17, 1056, -1, sc, 0.f, nullptr, 0, 0, mix, smem, (const u16*)(ws + W_CTR + 3968), store_en);
      } else {
        int j = it - N_MP - N_MS;
        int idx = j < N_RP ? xq * N_RP + j : 1024 + (xq * N_RS + j - N_RP) * 2 + (wave >> 1);
        int qt = j < N_RP ? wave : (wave & 1);
        p4_ret(p, l, idx, qt, store_en);
      }
    }
  }
}

__global__ void __launch_bounds__(256, 2) mega(Params p) {
  cg::grid_group grid = cg::this_grid();
  __shared__ __attribute__((aligned(16))) char smem[65536];
  __shared__ int s_item;
  __shared__ uint4 xb_words;
  char* ws = p.ws;
  int* ctr = (int*)(ws + W_CTR);
  if (__builtin_amdgcn_workitem_id_x() == 0) xb_words = make_uint4(0u, 0u, 0u, 0u);
  __syncthreads();
  const XcdBarrier xb = xcd_barrier_post((unsigned*)(ws + W_BAR), (volatile LAS unsigned*)&xb_words);
  if (gridDim.x > 65535u) grid.sync();
  const int wave = otid() >> 6, lane = otid() & 63;
  const int wm = wave >> 1, wn = wave & 1, l15 = lane & 15, g = lane >> 4;
  for (int l0 = 0; l0 < 2; ++l0) {
    const int l = olayer(l0);
    phase0(p, l, smem);
    if (DUP == 10) phase0(p, l, smem);
    xcd_barrier(xb);
    if (DUP == 9) { for (int i = 0; i < 5; ++i) xcd_barrier(xb); }
    gemm_tiles_dyn(ctr + 8 + l, &s_item, xb.x & 7, 136, 24, [&](int mp, int n) {
      f32x4 acc[4][4];
      if (DUP == 11) gemm_core((const u16*)(ws + W_H), 1024, (const u16*)(ws + W_WIN), 1024, 1024, mp * 128, n * 128, acc, smem);
      gemm_core((const u16*)(ws + W_H), 1024, (const u16*)(ws + W_WIN), 1024, 1024, mp * 128, n * 128, acc, smem);
      phase1_epilogue(p, l, acc, mp * 128, n * 128, smem);
    });
    if (DUP == 1) {
      for_gemm_tiles(136, 24, [&](int mp, int n) {
        f32x4 acc[4][4];
        gemm_core((const u16*)(ws + W_H), 1024, (const u16*)(ws + W_WIN), 1024, 1024, mp * 128, n * 128, acc, smem);
        phase1_epilogue(p, l, acc, mp * 128, n * 128, smem);
      });
    }
    xcd_barrier(xb);
    if (DUP == 2) phase2(p, l, smem, ctr + 512 + l * 2, &s_item, xb.x & 7, ctr[1000] != 0);
    phase2(p, l, smem, ctr + l * 2, &s_item, xb.x & 7);
    xcd_barrier(xb);
    phase3(p, l, smem, ctr + 4 + l * 2, &s_item, xb.x & 7);
    if (DUP == 3) phase3(p, l, smem, ctr + 516 + l * 2, &s_item, xb.x & 7);
    xcd_barrier(xb);
    if (DUP == 4) phase4(p, l, smem, ctr + 512 + l * 2 + 1, &s_item, xb.x & 7, ctr[1000] != 0);
    phase4(p, l, smem, ctr + l * 2 + 1, &s_item, xb.x & 7);
    xcd_barrier(xb);
    for (int rep = 0; rep < ((DUP == 5 && l == 0) ? 2 : 1); ++rep)
    for_gemm_tiles(136, 8, [&](int mp, int n) {
      f32x4 acc[4][4];
      gemm_core((const u16*)(ws + W_GATE), 1024, (const u16*)(ws + W_WOUT), 1024, 1024, mp * 128, n * 128, acc, smem);
      const int m0 = mp * 128, n0 = n * 128, tid5 = otid();
      float* Tf = (float*)smem;
      const float* xb = (l == 0) ? (m0 < PROW ? p.in[0] + (size_t)m0 * 1024 : p.in[1] + (size_t)(m0 - PROW) * 1024)
                                 : p.out + O_Y + (size_t)m0 * 1024;
      float* yb = p.out + O_Y + (size_t)m0 * 1024;
#pragma unroll
      for (int pass = 0; pass < 2; ++pass) {
        __syncthreads();
        if (wm == pass) {
#pragma unroll
          for (int mt = 0; mt < 4; ++mt)
#pragma unroll
            for (int nt = 0; nt < 4; ++nt)
#pragma unroll
              for (int j = 0; j < 4; ++j) Tf[(mt * 16 + g * 4 + j) * 132 + wn * 64 + nt * 16 + l15] = acc[mt][nt][j];
        }
        __syncthreads();
#pragma unroll
        for (int i = 0; i < 8; ++i) {
          int q = tid5 + i * 256, lr = q >> 5, cc = q & 31;
          size_t off = (size_t)(pass * 64 + lr) * 1024 + n0 + cc * 4;
          float4 tv = *(const float4*)(Tf + lr * 132 + cc * 4);
          float4 xv = ntld4(xb + off);
          float4 yv = make_float4(xv.x + tv.x, xv.y + tv.y, xv.z + tv.z, xv.w + tv.w);
          ntst4(yb + off, yv);
        }
      }
    });
    if (l0 == 0) xcd_barrier(xb);
  }
}

extern "C" void kernel_launch(void* const* d_in, const int* in_sizes, int n_in, void* d_out, int out_size, void* d_ws,
                              size_t ws_size, hipStream_t stream) {
  static int grid_blocks = 0;
  if (!grid_blocks) {
    int dev = 0, cus = 0, per_cu = 0;
    hipGetDevice(&dev);
    hipDeviceGetAttribute(&cus, hipDeviceAttributeMultiprocessorCount, dev);
    hipOccupancyMaxActiveBlocksPerMultiprocessor(&per_cu, mega, 256, 0);
    if (per_cu > 2) per_cu = 2;
    if (per_cu < 1) per_cu = 1;
    grid_blocks = cus * per_cu;
  }
  Params p{};
  for (int i = 0; i < 22; ++i) p.in[i] = (const float*)d_in[i];
  p.out = (float*)d_out;
  p.ws = (char*)d_ws;
  hipMemsetAsync((char*)d_ws + W_CTR, 0, 4096 + 16384, stream);
  void* args[] = {&p};
  hipError_t e = hipLaunchCooperativeKernel((void*)mega, dim3(grid_blocks), dim3(256), args, 0, stream);
  if (e != hipSuccess) fprintf(stderr, "cooperative launch failed: %s (grid %d)\n", hipGetErrorString(e), grid_blocks);
}
```

```cpp
#include <hip/hip_runtime.h>
#include <hip/hip_cooperative_groups.h>
#include <cstdio>
namespace cg = cooperative_groups;
#ifndef DUP
#define DUP 0
#endif

typedef unsigned short u16;
typedef __attribute__((ext_vector_type(8))) short bf16x8;
typedef __attribute__((ext_vector_type(4))) short bf16x4;
typedef __attribute__((ext_vector_type(4))) float f32x4;
typedef __attribute__((ext_vector_type(2))) float f32x2;
typedef __attribute__((ext_vector_type(2))) __bf16 bfx2;
#define DI __device__ __forceinline__
#define MFMA(a, b, c) __builtin_amdgcn_mfma_f32_16x16x32_bf16((a), (b), (c), 0, 0, 0)

constexpr int NROW = 17408;
constexpr int PROW = 16384;
constexpr int KVROWS = 50176;
constexpr int BKROWS = 33792;
constexpr float EPSV = 1e-6f;
constexpr float LOG2E = 1.4426950408889634f;
constexpr float LOG2_1E4 = 13.287712379549449f;

constexpr size_t O_Y = 0;
constexpr size_t O_PSTATE = 17825792;
constexpr size_t O_PCKV = 17891328;
constexpr size_t O_PKR = 22085632;
constexpr size_t O_PBK = 23134208;
constexpr size_t O_PBV = 23658496;
constexpr size_t O_SSTATE = 24182784;
constexpr size_t O_SCKV = 25231360;
constexpr size_t O_SKR = 25493504;
constexpr size_t O_SBK = 25559040;
constexpr size_t O_SBV = 26083328;

constexpr size_t W_WIN = 0;
constexpr size_t W_WUQ = W_WIN + 3072ull * 1024 * 2;
constexpr size_t W_WUKV = W_WUQ + 768ull * 256 * 2;
constexpr size_t W_WOUT = W_WUKV + 1024ull * 128 * 2;
constexpr size_t W_H = W_WOUT + 1024ull * 1024 * 2;
constexpr size_t W_RETQ = W_H + (size_t)NROW * 1024 * 2;
constexpr size_t W_RETK = W_RETQ + (size_t)NROW * 256 * 2;
constexpr size_t W_RETVT = W_RETK + (size_t)NROW * 256 * 2;
constexpr size_t W_GATE = W_RETVT + (size_t)NROW * 256 * 2;
constexpr size_t W_KR = W_GATE + (size_t)NROW * 1024 * 2;
constexpr size_t W_KNOPE = W_KR + (size_t)KVROWS * 32 * 2;
constexpr size_t W_VT = W_KNOPE + (size_t)KVROWS * 512 * 2;
constexpr size_t W_KVEND = W_VT + (size_t)KVROWS * 512 * 2;
constexpr size_t W_ZRAW = W_KNOPE;
constexpr size_t W_RETKZT = W_ZRAW + (size_t)NROW * 416 * 4;
constexpr size_t W_BQ = W_RETKZT + (size_t)NROW * 256 * 2;
constexpr size_t W_BK = W_BQ + (size_t)NROW * 256 * 2;
constexpr size_t W_BVT = W_BK + (size_t)BKROWS * 256 * 2;
static_assert(W_BVT + (size_t)BKROWS * 256 * 2 <= W_KVEND, "alias overflow");
constexpr size_t W_CQ = W_KVEND;
constexpr size_t W_CKV = W_CQ + (size_t)NROW * 256 * 2;
constexpr size_t W_KVC = W_CKV + (size_t)KVROWS * 128 * 2;
constexpr size_t W_SST = W_KVC + 1152ull * 4096 * 4;
constexpr size_t W_CTR = W_SST + 1152ull * 4096 * 2;
constexpr size_t W_BAR = W_CTR + 4096;
constexpr size_t W_TOTAL = W_BAR + 16384;
static_assert(W_TOTAL <= 268435456ull, "workspace too large");

struct Params {
  const float* in[22];
  float* out;
  char* ws;
};

DI int otid() { int t = __builtin_amdgcn_workitem_id_x(); asm volatile("" : "+v"(t)); return t; }
DI int olayer(int l) { asm volatile("" : "+s"(l)); return l; }
DI unsigned pack2(float a, float b) {
  f32x2 v = {a, b};
  bfx2 r = __builtin_convertvector(v, bfx2);
  return __builtin_bit_cast(unsigned, r);
}
DI u16 f2bf(float a) { return (u16)(pack2(a, 0.f) & 0xffffu); }
DI bf16x4 pack4(float a, float b, float c, float d) {
  uint2 u = make_uint2(pack2(a, b), pack2(c, d));
  return __builtin_bit_cast(bf16x4, u);
}
DI float4 ntld4(const float* p) { f32x4 v = __builtin_nontemporal_load((const f32x4*)p); return make_float4(v[0], v[1], v[2], v[3]); }
DI float ntld1(const float* p) { return __builtin_nontemporal_load(p); }
DI void ntst4(float* p, float4 v) { f32x4 t = {v.x, v.y, v.z, v.w}; __builtin_nontemporal_store(t, (f32x4*)p); }
DI float bf2f(u16 v) { return __uint_as_float(((unsigned)v) << 16); }
DI float ex2(float x) { return __builtin_amdgcn_exp2f(x); }
DI float gamma_lg2(int h) {
  return h == 0 ? -0.04580368961312479f : (h == 1 ? -0.02272007650008353f : (h == 2 ? -0.011315313227834146f : -0.005646563141142063f));
}
DI void rope_cs(int pos, int i, float neg_l2b_over_half, float& c, float& s) {
  float inv = ex2((float)i * neg_l2b_over_half);
  float ang = (float)pos * inv;
  const float CH = 0.15915493667125702f, CL = 6.420638326565253e-09f;
  float rev = ang * CH;
  float err = fmaf(ang, CH, -rev) + ang * CL;
  float fr = (rev - rintf(rev)) + err;
  s = __builtin_amdgcn_sinf(fr);
  c = __builtin_amdgcn_cosf(fr);
}
DI void row_info(int row, int& seq, int& t, int& pos) {
  if (row < PROW) { seq = row >> 13; t = row & 8191; pos = t; }
  else { int r = row - PROW; seq = 2 + (r >> 5); t = r & 31; pos = 1024 + t; }
}
template <int CTRL>
DI float dppf(float v) { return __builtin_bit_cast(float, __builtin_amdgcn_update_dpp(0, __builtin_bit_cast(int, v), CTRL, 0xf, 0xf, false)); }
DI float red16(float v) {
  v += dppf<0x128>(v); v += dppf<0x124>(v); v += dppf<0x122>(v); v += dppf<0x121>(v);
  return v;
}
DI float redg(float v) {
  v += __shfl_xor(v, 16); v += __shfl_xor(v, 32);
  return v;
}
DI float red64(float v) { return redg(red16(v)); }
DI float silu(float x) { return x * __builtin_amdgcn_rcpf(1.f + ex2(-x * LOG2E)); }

DI size_t ret_t_addr(int seq, int t, int h, int d) {
  return seq < 2 ? ((size_t)((seq * 4 + h) * 64 + d) * 8192 + t) : (4194304ull + (size_t)(((seq - 2) * 4 + h) * 64 + d) * 32 + t);
}
DI size_t band_t_addr(int seq, int tk, int h, int d) {
  return seq < 2 ? ((size_t)((seq * 4 + h) * 64 + d) * 8192 + tk) : (4194304ull + (size_t)(((seq - 2) * 4 + h) * 64 + d) * 544 + tk);
}
DI size_t mla_t_addr(int seq, int tk, int h, int d) {
  return seq < 2 ? ((size_t)((seq * 8 + h) * 64 + d) * 8192 + tk) : (8388608ull + (size_t)(((seq - 2) * 8 + h) * 64 + d) * 1056 + tk);
}

#define XB_TMO      128
#define XB_XCNT(j)  (256  + 64 * (j))
#define XB_XSUB(j)  (1280 + 64 * (j))
#define XB_XGEN(j)  (2304 + 64 * (j))
#define XB_TOP      3328
#define XB_TOPGEN   3392
#define XCD_BAR_WORDS 3456
#define XB_SPIN_CAP (1u << 22)
#define LAS __attribute__((address_space(3)))
DI unsigned xb_ld(unsigned* p) { return __hip_atomic_load(p, __ATOMIC_RELAXED, __HIP_MEMORY_SCOPE_AGENT); }
DI unsigned xb_add(unsigned* p, unsigned v) { return __hip_atomic_fetch_add(p, v, __ATOMIC_RELAXED, __HIP_MEMORY_SCOPE_AGENT); }
DI unsigned xb_xcc_id() { return (unsigned)__builtin_amdgcn_s_getreg((3 << 11) | 20) & 0xFu; }
#define XB_SPIN(cond, bar) do { unsigned _sp = 0; while (cond) { __builtin_amdgcn_s_sleep(1); \
    if ((++_sp & 255u) == 0u) { if (xb_ld(&(bar)[XB_TMO])) break; if (_sp > XB_SPIN_CAP) { atomicAdd(&(bar)[XB_TMO], 1u); break; } } } } while (0)
struct XcdBarrier { unsigned* bar; unsigned x; volatile LAS unsigned* st; };
DI XcdBarrier xcd_barrier_post(unsigned* bar, volatile LAS unsigned* st) {
  XcdBarrier b; b.bar = bar; b.x = xb_xcc_id(); b.st = st;
  if (__builtin_amdgcn_workitem_id_x() == 0) (void)xb_add(&bar[XB_XCNT(b.x)], 1u);
  return b;
}
DI void xcd_barrier_complete(unsigned* bar, unsigned x, unsigned& nloc, unsigned& nx) {
  const unsigned G = gridDim.x;
  unsigned sum, cnt, mine, sp = 0u;
  for (;;) {
    sum = 0u; cnt = 0u; mine = 0u;
#pragma unroll
    for (unsigned j = 0; j < 16; ++j) { const unsigned c = xb_ld(&bar[XB_XCNT(j)]); sum += c; cnt += (c > 0u) ? 1u : 0u; mine = (j == x) ? c : mine; }
    if (sum == G) break;
    __builtin_amdgcn_s_sleep(1);
    if ((++sp & 255u) == 0u) { if (xb_ld(&bar[XB_TMO])) break; if (sp > XB_SPIN_CAP) { atomicAdd(&bar[XB_TMO], 1u); break; } }
  }
  nloc = mine > 0u ? mine : 1u; nx = cnt > 0u ? cnt : 1u;
}
DI void xcd_barrier(const XcdBarrier& b) {
  asm volatile("s_waitcnt vmcnt(0)" ::: "memory");
  __syncthreads();
  if (__builtin_amdgcn_workitem_id_x() == 0) {
    unsigned* bar = b.bar;
    __builtin_amdgcn_s_waitcnt(0);
    unsigned nloc = b.st[0], nx = b.st[1];
    if (nloc == 0u) { xcd_barrier_complete(bar, b.x, nloc, nx); b.st[0] = nloc; b.st[1] = nx; }
    const unsigned old = xb_add(&bar[XB_XSUB(b.x)], 1u);
    const unsigned gen = old / nloc;
    if (old + 1u == (gen + 1u) * nloc) {
      __builtin_amdgcn_fence(__ATOMIC_RELEASE, "agent");
      asm volatile("s_waitcnt vmcnt(0)" ::: "memory");
      const unsigned og = xb_add(&bar[XB_TOP], 1u);
      const unsigned tg = og / nx;
      if (og + 1u == (tg + 1u) * nx) xb_add(&bar[XB_TOPGEN], 1u);
      else XB_SPIN(xb_ld(&bar[XB_TOPGEN]) == tg, bar);
      __builtin_amdgcn_fence(__ATOMIC_ACQUIRE, "agent");
      xb_add(&bar[XB_XGEN(b.x)], 1u);
      asm volatile("s_waitcnt vmcnt(0)" ::: "memory");
    } else {
      XB_SPIN(xb_ld(&bar[XB_XGEN(b.x)]) == gen, bar);
      __builtin_amdgcn_fence(__ATOMIC_ACQUIRE, "agent");
      asm volatile("s_waitcnt vmcnt(0)" ::: "memory");
    }
  }
  __syncthreads();
}

constexpr int GSTAGE_B = 16384;
#define RAW_BARRIER() do { asm volatile("s_waitcnt lgkmcnt(0)" ::: "memory"); __builtin_amdgcn_s_barrier(); } while (0)
DI void gemm_core(const u16* __restrict__ A, int lda, const u16* __restrict__ Bt, int ldb, int K, int m0, int n0,
                  f32x4 (&acc)[4][4], char* smem) {
  const int tid = otid(), lane = tid & 63, wave = __builtin_amdgcn_readfirstlane(tid >> 6);
  const int wm = wave >> 1, wn = wave & 1, l15 = lane & 15, g = lane >> 4;
  const int r0 = wave * 32 + (lane >> 2);
  const int cs = ((lane & 3) ^ ((r0 >> 2) & 3)) * 8;
  const u16* ap0 = A + (size_t)(m0 + r0) * lda + cs;
  const u16* ap1 = ap0 + (size_t)16 * lda;
  const u16* bp0 = Bt + (size_t)(n0 + r0) * ldb + cs;
  const u16* bp1 = bp0 + (size_t)16 * ldb;
  char* ldsA = smem + (wave * 32) * 64;
#pragma unroll
  for (int mt = 0; mt < 4; ++mt)
#pragma unroll
    for (int nt = 0; nt < 4; ++nt) acc[mt][nt] = f32x4{0.f, 0.f, 0.f, 0.f};
#define GL(stg, k) { \
    __builtin_amdgcn_global_load_lds((const unsigned*)(ap0 + (k)), (unsigned*)(ldsA + (stg) * GSTAGE_B), 16, 0, 0); \
    __builtin_amdgcn_global_load_lds((const unsigned*)(ap1 + (k)), (unsigned*)(ldsA + (stg) * GSTAGE_B + 1024), 16, 0, 0); \
    __builtin_amdgcn_global_load_lds((const unsigned*)(bp0 + (k)), (unsigned*)(ldsA + (stg) * GSTAGE_B + 8192), 16, 0, 0); \
    __builtin_amdgcn_global_load_lds((const unsigned*)(bp1 + (k)), (unsigned*)(ldsA + (stg) * GSTAGE_B + 8192 + 1024), 16, 0, 0); }
  const int co = (g ^ (l15 >> 2)) * 16;
  const int arow = (wm * 64 + l15) * 64 + co, brow = 8192 + (wn * 64 + l15) * 64 + co;
  const int kmask = K - 1;
  const int kofs = ((int)(blockIdx.x >> 3) * 64) & kmask;
  const int nstep = K >> 5;
  const unsigned lds_base = (unsigned)(size_t)smem;
  __syncthreads();
  GL(0, kofs)
  GL(1, ((kofs + 32) & kmask))
  GL(2, ((kofs + 64) & kmask))
  for (int t = 0; t < nstep; ++t) {
    asm volatile("s_waitcnt vmcnt(8)" ::: "memory");
    RAW_BARRIER();
    GL(((t + 3) & 3), ((kofs + (t + 3) * 32) & kmask))
    const unsigned aaddr = lds_base + (t & 3) * GSTAGE_B + arow, baddr = lds_base + (t & 3) * GSTAGE_B + brow;
    bf16x8 af[4], bfr[4];
    asm volatile("ds_read_b128 %0, %8\n\tds_read_b128 %1, %8 offset:1024\n\tds_read_b128 %2, %8 offset:2048\n\tds_read_b128 %3, %8 offset:3072\n\t"
                 "ds_read_b128 %4, %9\n\tds_read_b128 %5, %9 offset:1024\n\tds_read_b128 %6, %9 offset:2048\n\tds_read_b128 %7, %9 offset:3072\n\t"
                 "s_waitcnt lgkmcnt(0)"
                 : "=&v"(af[0]), "=&v"(af[1]), "=&v"(af[2]), "=&v"(af[3]), "=&v"(bfr[0]), "=&v"(bfr[1]), "=&v"(bfr[2]), "=&v"(bfr[3])
                 : "v"(aaddr), "v"(baddr)
                 : "memory");
#pragma unroll
    for (int mt = 0; mt < 4; ++mt)
#pragma unroll
      for (int nt = 0; nt < 4; ++nt) acc[mt][nt] = MFMA(af[mt], bfr[nt], acc[mt][nt]);
  }
  asm volatile("s_waitcnt vmcnt(0)" ::: "memory");
}

template <class F>
DI void for_gemm_tiles(int MP, int NT, F f) {
  const int G = gridDim.x, bid = blockIdx.x;
  const int nx = G >> 3, xcd = bid & 7, loc = bid >> 3;
  const int mpx = MP >> 3, per = mpx * NT;
  for (int i = loc; i < per; i += nx) f(xcd * mpx + i / NT, i % NT);
}

template <class F>
DI void gemm_tiles_dyn(int* ctr, int* s_item, int xcd, int MP, int NT, F f) {
  const int tid = otid();
  const int mpx = MP >> 3, per = mpx * NT;
  for (int qi = 0; qi < 8; ++qi) {
    const int xq = (xcd + qi) & 7;
    for (;;) {
      __syncthreads();
      if (tid == 0) *s_item = atomicAdd(ctr + xq * 32, 1);
      __syncthreads();
      const int i = __builtin_amdgcn_readfirstlane(*s_item);
      if (i >= per) break;
      if ((NT & 7) == 0) {
        const int grp = mpx * 8, ng = i / grp, r = i - ng * grp;
        f(xq * mpx + (r >> 3), ng * 8 + (r & 7));
      } else f(xq * mpx + i / NT, i % NT);
    }
  }
}

DI void transpose_tile(const float* __restrict__ src, int srcN, int k0, int srcn0, bool zero, u16* dst, int dstK, int dn0, char* smem) {
  u16* t = (u16*)smem;
  const int tid = otid();
  __syncthreads();
  const int nn = tid & 31, kb = tid >> 5;
#pragma unroll
  for (int i = 0; i < 8; ++i) {
    int kk = kb + i * 8;
    float v = zero ? 0.f : ntld1(src + (size_t)(k0 + kk) * srcN + srcn0 + nn);
    t[nn * 72 + kk] = f2bf(v);
  }
  __syncthreads();
  const int r = tid >> 3, c = (tid & 7) * 8;
  *(uint4*)(dst + (size_t)(dn0 + r) * dstK + k0 + c) = *(const uint4*)(t + r * 72 + c);
}

DI void phase0(const Params& p, int l, char* smem) {
  const int G = gridDim.x, bid = blockIdx.x, tid = otid(), lane = tid & 63, wave = tid >> 6;
  char* ws = p.ws;
  {
    const float* w_in = p.in[8] + (size_t)l * 1024 * 2976;
    const float* w_uq = p.in[11] + (size_t)l * 256 * 768;
    const float* w_ukv = p.in[16] + (size_t)l * 128 * 1024;
    const float* w_out = p.in[21] + (size_t)l * 1024 * 1024;
    for (int it = bid; it < 2208; it += G) {
      if (it < 1536) {
        int nt = it >> 4, kt = it & 15, dn = nt * 32;
        int sn = dn < 1408 ? dn : (dn < 2944 ? dn + 32 : dn - 1536);
        bool zero = dn >= 2976;
        transpose_tile(w_in, 2976, kt * 64, zero ? 0 : sn, zero, (u16*)(ws + W_WIN), 1024, dn, smem);
      } else if (it < 1632) {
        int j = it - 1536, nt = j >> 2, kt = j & 3, dn = nt * 32;
        int sn = dn < 512 ? ((dn >> 6) * 96 + (dn & 63)) : (((dn - 512) >> 5) * 96 + 64);
        transpose_tile(w_uq, 768, kt * 64, sn, false, (u16*)(ws + W_WUQ), 256, dn, smem);
      } else if (it < 1696) {
        int j = it - 1632, nt = j >> 1, kt = j & 1;
        transpose_tile(w_ukv, 1024, kt * 64, nt * 32, false, (u16*)(ws + W_WUKV), 128, nt * 32, smem);
      } else {
        int j = it - 1696, nt = j >> 4, kt = j & 15;
        transpose_tile(w_out, 1024, kt * 64, nt * 32, false, (u16*)(ws + W_WOUT), 1024, nt * 32, smem);
      }
    }
  }
  {
    const float* __restrict__ ng = p.in[7] + l * 1024;
    u16* __restrict__ hbuf = (u16*)(ws + W_H);
    const int l15 = lane & 15, g = lane >> 4;
    for (int r0 = (bid * 4 + wave) * 4; r0 < NROW; r0 += G * 16) {
      const int row = r0 + g;
      const float* __restrict__ x = (l == 0) ? (row < PROW ? p.in[0] + (size_t)row * 1024 : p.in[1] + (size_t)(row - PROW) * 1024)
                                             : p.out + O_Y + (size_t)row * 1024;
      float4 v[16];
      float ss = 0.f;
#pragma unroll
      for (int i = 0; i < 16; ++i) v[i] = ntld4(x + (i * 16 + l15) * 4);
#pragma unroll
      for (int i = 0; i < 16; ++i) ss += v[i].x * v[i].x + v[i].y * v[i].y + v[i].z * v[i].z + v[i].w * v[i].w;
      ss = red16(ss);
      const float r = __builtin_amdgcn_rsqf(ss * (1.f / 1024.f) + EPSV);
#pragma unroll
      for (int i = 0; i < 16; ++i) {
        int c = (i * 16 + l15) * 4;
        float4 gg = *(const float4*)(ng + c);
        *(uint2*)(hbuf + (size_t)row * 1024 + c) = make_uint2(pack2(v[i].x * r * gg.x, v[i].y * r * gg.y), pack2(v[i].z * r * gg.z, v[i].w * r * gg.w));
      }
    }
  }
  const int gt = bid * 256 + tid, gn = G * 256;
  {
    const float* __restrict__ c_ckv = p.in[3] + (size_t)l * 32 * 1024 * 128;
    u16* __restrict__ ckv = (u16*)(ws + W_CKV);
#pragma unroll 4
    for (int i = gt; i < 32 * 1024 * 128 / 8; i += gn) {
      int e = i * 8, b = e >> 17, rem = e & 131071;
      const float4* s = (const float4*)(c_ckv + e);
      float4 a = ntld4((const float*)s), c = ntld4((const float*)s + 4);
      uint4 o = make_uint4(pack2(a.x, a.y), pack2(a.z, a.w), pack2(c.x, c.y), pack2(c.z, c.w));
      *(uint4*)(ckv + (size_t)(PROW + b * 1056) * 128 + rem) = o;
    }
    const float* __restrict__ c_kr = p.in[4] + (size_t)l * 32 * 1024 * 32;
    u16* __restrict__ kr = (u16*)(ws + W_KR);
    for (int i = gt; i < 32 * 1024 * 32 / 8; i += gn) {
      int e = i * 8, b = e >> 15, rem = e & 32767;
      const float4* s = (const float4*)(c_kr + e);
      float4 a = ntld4((const float*)s), c = ntld4((const float*)s + 4);
      uint4 o = make_uint4(pack2(a.x, a.y), pack2(a.z, a.w), pack2(c.x, c.y), pack2(c.z, c.w));
      *(uint4*)(kr + (size_t)(PROW + b * 1056) * 32 + rem) = o;
    }
    const float* __restrict__ c_bk = p.in[5] + (size_t)l * 32 * 512 * 256;
    u16* __restrict__ bk = (u16*)(ws + W_BK);
#pragma unroll 4
    for (int i = gt; i < 32 * 512 * 256 / 8; i += gn) {
      int e = i * 8, b = e >> 17, rem = e & 131071;
      const float4* s = (const float4*)(c_bk + e);
      float4 a = ntld4((const float*)s), c = ntld4((const float*)s + 4);
      uint4 o = make_uint4(pack2(a.x, a.y), pack2(a.z, a.w), pack2(c.x, c.y), pack2(c.z, c.w));
      *(uint4*)(bk + (size_t)(PROW + b * 544) * 256 + rem) = o;
    }
    const float* __restrict__ c_bv = p.in[6] + (size_t)l * 32 * 512 * 256;
    u16* __restrict__ bvt = (u16*)(ws + W_BVT);
#pragma unroll 4
    for (int i = gt; i < 32 * 128 * 256; i += gn) {
      int col = i & 255, j4 = (i >> 8) & 127, b = i >> 15;
      const float* s = c_bv + ((size_t)(b * 512 + j4 * 4)) * 256 + col;
      bf16x4 o = pack4(ntld1(s), ntld1(s + 256), ntld1(s + 512), ntld1(s + 768));
      *(bf16x4*)(bvt + band_t_addr(2 + b, j4 * 4, col >> 6, col & 63)) = o;
    }
    const float* __restrict__ st = p.in[2] + (size_t)l * 32 * 4 * 4096;
    u16* __restrict__ sst = (u16*)(ws + W_SST) + 1024ull * 4096;
#pragma unroll 4
    for (int i = gt; i < 128 * 4096; i += gn) {
      int d = i & 63, e = (i >> 6) & 63, bh = i >> 12;
      sst[i] = f2bf(ntld1(st + (size_t)bh * 4096 + d * 64 + e));
    }
  }
}

constexpr int TS = 136;
DI void stage_rm(u16* T, int wm, int wn, int g, int l15, int mt, int nt, int j, float v) {
  T[(wm * 64 + mt * 16 + g * 4 + j) * TS + wn * 64 + nt * 16 + l15] = f2bf(v);
}
DI void stage_tr(u16* T, int wm, int wn, int g, int l15, int mt, int nt, const f32x4& v) {
  *(bf16x4*)(T + (wn * 64 + nt * 16 + l15) * TS + wm * 64 + mt * 16 + g * 4) = pack4(v[0], v[1], v[2], v[3]);
}
template <int NROWS, int NCH, class F>
DI void tile_copy_out(const u16* T, int tid, F dst) {
#pragma unroll
  for (int i = 0; i < NROWS * NCH / 256; ++i) {
    int q = tid + i * 256, lr = q / NCH, cc = q % NCH;
    u16* d = dst(lr, cc);
    if (d) *(uint4*)d = *(const uint4*)(T + lr * TS + cc * 8);
  }
}

DI void phase1_epilogue(const Params& p, int l, f32x4 (&acc)[4][4], int m0, int n0, char* smem) {
  char* ws = p.ws;
  const int tid = otid(), lane = tid & 63, wave = tid >> 6;
  const int wm = wave >> 1, wn = wave & 1, l15 = lane & 15, g = lane >> 4;
  const int cb = n0 + wn * 64;
  const int rb = m0 + wm * 64;
  u16* T = (u16*)smem;
  __syncthreads();
  if (n0 < 512) {
    const bool isk = n0 >= 256;
    const int h = (cb & 255) >> 6;
    const float lg = gamma_lg2(h);
#pragma unroll
    for (int mt = 0; mt < 4; ++mt) {
#pragma unroll
      for (int j = 0; j < 4; ++j) {
        int row = rb + mt * 16 + g * 4 + j, seq, t, pos;
        row_info(row, seq, t, pos);
        float zeta = 1.f, sc = 1.f;
        if (isk) {
          sc = 0.125f;
          int e = row < PROW ? 63 - (t & 63) : 31 - t;
          zeta = ex2(lg * (float)e);
        }
#pragma unroll
        for (int nt = 0; nt < 2; ++nt) {
          int i = nt * 16 + l15;
          float c, s;
          rope_cs(pos, i, -LOG2_1E4 / 32.f, c, s);
          float x1 = acc[mt][nt][j] * sc, x2 = acc[mt][nt + 2][j] * sc;
          float o1 = x1 * c - x2 * s, o2 = x1 * s + x2 * c;
          stage_rm(T, wm, wn, g, l15, mt, nt, j, o1);
          stage_rm(T, wm, wn, g, l15, mt, nt + 2, j, o2);
          acc[mt][nt][j] = o1 * zeta;
          acc[mt][nt + 2][j] = o2 * zeta;
        }
      }
    }
    __syncthreads();
    {
      u16* dst = (u16*)(ws + (isk ? W_RETK : W_RETQ)) + (size_t)m0 * 256 + (n0 & 255);
      tile_copy_out<128, 16>(T, tid, [&](int lr, int cc) { return dst + (size_t)lr * 256 + cc * 8; });
    }
    if (isk) {
      __syncthreads();
#pragma unroll
      for (int mt = 0; mt < 4; ++mt)
#pragma unroll
        for (int nt = 0; nt < 4; ++nt) stage_tr(T, wm, wn, g, l15, mt, nt, acc[mt][nt]);
      __syncthreads();
      u16* kzt = (u16*)(ws + W_RETKZT);
      const int h0 = (n0 & 255) >> 6;
      tile_copy_out<128, 16>(T, tid, [&](int lr, int cc) {
        int seq, t, pos;
        row_info(m0 + cc * 8, seq, t, pos);
        return kzt + ret_t_addr(seq, t, h0 + (lr >> 6), lr & 63);
      });
    }
  } else if (n0 < 768) {
#pragma unroll
    for (int mt = 0; mt < 4; ++mt)
#pragma unroll
      for (int nt = 0; nt < 4; ++nt) stage_tr(T, wm, wn, g, l15, mt, nt, acc[mt][nt]);
    __syncthreads();
    u16* vt = (u16*)(ws + W_RETVT);
    const int h0 = (n0 - 512) >> 6;
    tile_copy_out<128, 16>(T, tid, [&](int lr, int cc) {
      int seq, t, pos;
      row_info(m0 + cc * 8, seq, t, pos);
      return vt + ret_t_addr(seq, t, h0 + (lr >> 6), lr & 63);
    });
  } else if (n0 < 1024 || (n0 >= 1408 && n0 < 1920) || (n0 >= 2688 && n0 < 2944)) {
    const int gc0 = n0 < 1024 ? n0 - 768 : (n0 < 1920 ? n0 - 1408 + 256 : n0 - 2688 + 768);
#pragma unroll
    for (int mt = 0; mt < 4; ++mt)
#pragma unroll
      for (int j = 0; j < 4; ++j)
#pragma unroll
        for (int nt = 0; nt < 4; ++nt) stage_rm(T, wm, wn, g, l15, mt, nt, j, silu(acc[mt][nt][j]));
    __syncthreads();
    u16* gate = (u16*)(ws + W_GATE) + (size_t)m0 * 1024 + gc0;
    tile_copy_out<128, 16>(T, tid, [&](int lr, int cc) { return gate + (size_t)lr * 1024 + cc * 8; });
  } else if (n0 < 1408 || n0 >= 2944) {
    const int zc0 = n0 < 1408 ? n0 - 1024 : 384;
#pragma unroll
    for (int mt = 0; mt < 4; ++mt)
#pragma unroll
      for (int j = 0; j < 4; ++j)
#pragma unroll
        for (int nt = 0; nt < 4; ++nt) stage_rm(T, wm, wn, g, l15, mt, nt, j, acc[mt][nt][j]);
    __syncthreads();
    u16* zr = (u16*)(ws + W_ZRAW) + (size_t)m0 * 416 + zc0;
    tile_copy_out<128, 16>(T, tid, [&](int lr, int cc) { return (zc0 + cc * 8 < 416) ? zr + (size_t)lr * 416 + cc * 8 : (u16*)nullptr; });
  } else if (n0 < 2432) {
    const bool isk = n0 >= 2176;
    const int h = ((cb - 1920) & 255) >> 6;
    const float* gn = p.in[isk ? 19 : 18] + l * 64;
    float gv[4];
#pragma unroll
    for (int nt = 0; nt < 4; ++nt) gv[nt] = gn[nt * 16 + l15];
#pragma unroll
    for (int mt = 0; mt < 4; ++mt)
#pragma unroll
      for (int j = 0; j < 4; ++j) {
        int row = rb + mt * 16 + g * 4 + j, seq, t, pos;
        row_info(row, seq, t, pos);
        float ss = 0.f;
#pragma unroll
        for (int nt = 0; nt < 4; ++nt) ss += acc[mt][nt][j] * acc[mt][nt][j];
        ss = red16(ss);
        float r = __builtin_amdgcn_rsqf(ss * (1.f / 64.f) + EPSV);
#pragma unroll
        for (int nt = 0; nt < 4; ++nt) {
          float o = acc[mt][nt][j] * r * gv[nt];
          stage_rm(T, wm, wn, g, l15, mt, nt, j, o);
          if (isk) {
            int c = h * 64 + nt * 16 + l15;
            if (seq < 2) { if (t >= 7680) p.out[O_PBK + ((size_t)(l * 2 + seq) * 512 + (t - 7680)) * 256 + c] = o; }
            else p.out[O_SBK + ((size_t)(l * 32 + seq - 2) * 32 + t) * 256 + c] = o;
          }
        }
      }
    __syncthreads();
    const int c0 = (n0 - 1920) & 255;
    if (!isk) {
      u16* bq = (u16*)(ws + W_BQ) + (size_t)m0 * 256 + c0;
      tile_copy_out<128, 16>(T, tid, [&](int lr, int cc) { return bq + (size_t)lr * 256 + cc * 8; });
    } else {
      u16* bk = (u16*)(ws + W_BK) + c0;
      tile_copy_out<128, 16>(T, tid, [&](int lr, int cc) {
        int seq, t, pos;
        row_info(m0 + lr, seq, t, pos);
        size_t brow = seq < 2 ? (size_t)(m0 + lr) : (size_t)(PROW + (seq - 2) * 544 + 512 + t);
        return bk + brow * 256 + cc * 8;
      });
    }
  } else {
    const int h = (cb - 2432) >> 6;
#pragma unroll
    for (int mt = 0; mt < 4; ++mt) {
      int row0 = rb + mt * 16 + g * 4, seq, t, pos;
      row_info(row0, seq, t, pos);
#pragma unroll
      for (int nt = 0; nt < 4; ++nt) {
        stage_tr(T, wm, wn, g, l15, mt, nt, acc[mt][nt]);
        int c = h * 64 + nt * 16 + l15;
#pragma unroll
        for (int j = 0; j < 4; ++j) {
          if (seq < 2) { if (t + j >= 7680) p.out[O_PBV + ((size_t)(l * 2 + seq) * 512 + (t + j - 7680)) * 256 + c] = acc[mt][nt][j]; }
          else p.out[O_SBV + ((size_t)(l * 32 + seq - 2) * 32 + t + j) * 256 + c] = acc[mt][nt][j];
        }
      }
    }
    __syncthreads();
    u16* bvt = (u16*)(ws + W_BVT);
    const int h0 = (n0 - 2432) >> 6;
    tile_copy_out<128, 16>(T, tid, [&](int lr, int cc) {
      int seq, t, pos;
      row_info(m0 + cc * 8, seq, t, pos);
      return bvt + band_t_addr(seq, seq < 2 ? t : 512 + t, h0 + (lr >> 6), lr & 63);
    });
  }
}

constexpr int VS = 72;
template <int DQ, int QT, bool BIAS, bool STATICM>
DI void attn_item(const u16* __restrict__ qptr, int qstride, int nq_valid,
                  const u16* __restrict__ k0ptr, int k0stride, const u16* __restrict__ k1ptr, int k1stride,
                  const u16* __restrict__ vtptr, int vtstride,
                  int kt_begin, int kt_end, int kv_len, int causal_chunk0,
                  float scale_l2, float mshift, const float* bias_s, int qpos0, int kpos0,
                  u16* mixp, char* smem, const u16* zsrc, bool store_en = true, int rot = 0) {
  constexpr int KS = DQ + 8;
  constexpr int NKC = DQ / 8;
  constexpr int NKL = 64 * NKC / 256;
  constexpr int STAGE = 64 * KS + 64 * VS;
  u16* S0 = (u16*)smem;
  const int tid = otid(), lane = tid & 63, wave = tid >> 6, l15 = lane & 15, g = lane >> 4;
  const int qrow_w = wave * 16 * QT;
  const bool active = qrow_w < nq_valid;
  int tile_end_w = kt_end;
  if (causal_chunk0 >= 0) { int e = causal_chunk0 + (qrow_w >> 6) + 1; tile_end_w = e < kt_end ? e : kt_end; }

  bf16x8 qf[QT][DQ / 32];
  if (active) {
#pragma unroll
    for (int qt = 0; qt < QT; ++qt)
#pragma unroll
      for (int ks = 0; ks < DQ / 32; ++ks)
        qf[qt][ks] = *(const bf16x8*)(qptr + (size_t)(qrow_w + qt * 16 + l15) * qstride + ks * 32 + g * 8);
  } else {
#pragma unroll
    for (int qt = 0; qt < QT; ++qt)
#pragma unroll
      for (int ks = 0; ks < DQ / 32; ++ks) qf[qt][ks] = bf16x8{0, 0, 0, 0, 0, 0, 0, 0};
  }
  f32x4 o[4][QT];
  float mrow[QT], lsum[QT];
#pragma unroll
  for (int qt = 0; qt < QT; ++qt) {
    mrow[qt] = -1e30f; lsum[qt] = 0.f;
#pragma unroll
    for (int dvt = 0; dvt < 4; ++dvt) o[dvt][qt] = f32x4{0.f, 0.f, 0.f, 0.f};
  }
  uint4 pk0, pk1, pk2, pv0, pv1;
  pk2 = make_uint4(0, 0, 0, 0);
#define AKPTR(i) const u16* kp##i; int kstep##i, kkey##i; { int c = tid + i * 256, key = c / NKC, part = c % NKC; kkey##i = key; \
    const bool rp = (DQ == 96) && part >= 8; \
    kp##i = rp ? k1ptr + (size_t)key * k1stride + (part - 8) * 8 : k0ptr + (size_t)key * k0stride + part * 8; \
    kstep##i = (rp ? k1stride : k0stride) * 64; }
  AKPTR(0) AKPTR(1) AKPTR(2)
  const int vdv0 = tid >> 3, vkc = (tid & 7) * 8;
  const u16* vp0 = vtptr + (size_t)vdv0 * vtstride + vkc;
  const u16* vp1 = vtptr + (size_t)(vdv0 + 32) * vtstride + vkc;
#define AKLD(S, i, tile) { const u16* a_ = kp##i + (size_t)(tile) * kstep##i; if ((tile) * 64 + kkey##i >= kv_len) a_ = zsrc; S##k##i = *(const uint4*)a_; }
#define AVLD(S, i, tile) { const u16* a_ = vp##i + (tile) * 64; if ((tile) * 64 + vkc >= kv_len) a_ = zsrc; S##v##i = *(const uint4*)a_; }
#define AKST(S, i, st) { int c = tid + i * 256, key = c / NKC, part = c % NKC; *(uint4*)((st) + key * KS + part * 8) = S##k##i; }
#define AVST(S, i, st) { int c = tid + i * 256, dv = c >> 3, kc = c & 7; *(uint4*)((st) + 64 * KS + dv * VS + kc * 8) = S##v##i; }
#define AGLOAD(S, tile) { AKLD(S, 0, tile) AKLD(S, 1, tile) if (NKL > 2) AKLD(S, 2, tile) AVLD(S, 0, tile) AVLD(S, 1, tile) }
#define ALSTORE(S, st) { AKST(S, 0, st) AKST(S, 1, st) if (NKL > 2) AKST(S, 2, st) AVST(S, 0, st) AVST(S, 1, st) }
  auto compute = [&](const int tile, const u16* Ks) {
    const u16* Vs = Ks + 64 * KS;
    if (active && tile < tile_end_w) {
      f32x4 s[4][QT];
#pragma unroll
      for (int kt = 0; kt < 4; ++kt)
#pragma unroll
        for (int qt = 0; qt < QT; ++qt) s[kt][qt] = f32x4{0.f, 0.f, 0.f, 0.f};
      {
        bf16x8 kf[4], kn[4];
#pragma unroll
        for (int kt = 0; kt < 4; ++kt) kf[kt] = *(const bf16x8*)(Ks + (kt * 16 + l15) * KS + g * 8);
#pragma unroll
        for (int ks = 0; ks < DQ / 32; ++ks) {
          if (ks + 1 < DQ / 32) {
#pragma unroll
            for (int kt = 0; kt < 4; ++kt) kn[kt] = *(const bf16x8*)(Ks + (kt * 16 + l15) * KS + (ks + 1) * 32 + g * 8);
          }
#pragma unroll
          for (int kt = 0; kt < 4; ++kt)
#pragma unroll
            for (int qt = 0; qt < QT; ++qt) s[kt][qt] = MFMA(kf[kt], qf[qt][ks], s[kt][qt]);
          if (ks + 1 < DQ / 32) {
#pragma unroll
            for (int kt = 0; kt < 4; ++kt) kf[kt] = kn[kt];
          }
        }
      }
      if (STATICM) {
#pragma unroll
        for (int qt = 0; qt < QT; ++qt) {
          float ps = 0.f;
#pragma unroll
          for (int kt = 0; kt < 4; ++kt)
#pragma unroll
            for (int j = 0; j < 4; ++j) {
              float pe = ex2(fmaf(s[kt][qt][j], scale_l2, -mshift));
              s[kt][qt][j] = pe;
              ps += pe;
            }
          lsum[qt] += ps;
        }
      } else {
        const bool partial = tile * 64 + 64 > kv_len;
        bool farbias = false;
        if (BIAS) farbias = (qpos0 - (kpos0 + tile * 64 + 63)) >= 128;
#pragma unroll
        for (int qt = 0; qt < QT; ++qt) {
          float mx = -1e30f;
          const int qp = qpos0 + qrow_w + qt * 16 + l15;
#pragma unroll
          for (int kt = 0; kt < 4; ++kt)
#pragma unroll
            for (int j = 0; j < 4; ++j) {
              int key = tile * 64 + kt * 16 + g * 4 + j;
              float v = s[kt][qt][j] * scale_l2;
              if (BIAS) {
                if (farbias) v += bias_s[256];
                else {
                  int d = qp - (kpos0 + key);
                  d = d < -128 ? -128 : (d > 128 ? 128 : d);
                  v += bias_s[d + 128];
                }
              }
              if (partial && key >= kv_len) v = -1e30f;
              s[kt][qt][j] = v;
              mx = fmaxf(mx, v);
            }
          mx = fmaxf(mx, __shfl_xor(mx, 16));
          mx = fmaxf(mx, __shfl_xor(mx, 32));
          float mn = fmaxf(mrow[qt], mx);
          float alpha = ex2(mrow[qt] - mn);
          mrow[qt] = mn;
          float ps = 0.f;
#pragma unroll
          for (int kt = 0; kt < 4; ++kt)
#pragma unroll
            for (int j = 0; j < 4; ++j) {
              float pe = ex2(s[kt][qt][j] - mn);
              s[kt][qt][j] = pe;
              ps += pe;
            }
          lsum[qt] = lsum[qt] * alpha + ps;
#pragma unroll
          for (int dvt = 0; dvt < 4; ++dvt) o[dvt][qt] *= alpha;
        }
      }
#pragma unroll
      for (int si = 0; si < 2; ++si) {
        bf16x8 pf[QT];
#pragma unroll
        for (int qt = 0; qt < QT; ++qt) {
          uint4 u = make_uint4(pack2(s[2 * si][qt][0], s[2 * si][qt][1]), pack2(s[2 * si][qt][2], s[2 * si][qt][3]),
                               pack2(s[2 * si + 1][qt][0], s[2 * si + 1][qt][1]), pack2(s[2 * si + 1][qt][2], s[2 * si + 1][qt][3]));
          pf[qt] = __builtin_bit_cast(bf16x8, u);
        }
        bf16x8 vf[4];
#pragma unroll
        for (int dvt = 0; dvt < 4; ++dvt) {
          bf16x4 lo = *(const bf16x4*)(Vs + (dvt * 16 + l15) * VS + si * 32 + g * 4);
          bf16x4 hi = *(const bf16x4*)(Vs + (dvt * 16 + l15) * VS + si * 32 + 16 + g * 4);
          vf[dvt] = __builtin_shufflevector(lo, hi, 0, 1, 2, 3, 4, 5, 6, 7);
        }
#pragma unroll
        for (int dvt = 0; dvt < 4; ++dvt)
#pragma unroll
          for (int qt = 0; qt < QT; ++qt) o[dvt][qt] = MFMA(vf[dvt], pf[qt], o[dvt][qt]);
      }
    }
  };
  u16* S1 = S0 + STAGE;
  const int ntile = kt_end - kt_begin;
  int tcur = kt_begin + rot;
#define TNEXT(t) (((t) + 1 == kt_end) ? kt_begin : (t) + 1)
  int t1 = TNEXT(tcur);
  AGLOAD(p, tcur)
  ALSTORE(p, S0)
  AGLOAD(p, t1)
  for (int i = 0; i < ntile; i += 2) {
    __syncthreads();
    const int t2 = TNEXT(t1);
    ALSTORE(p, S1)
    AGLOAD(p, t2)
    compute(tcur, S0);
    if (i + 1 >= ntile) break;
    __syncthreads();
    const int t3 = TNEXT(t2);
    ALSTORE(p, S0)
    AGLOAD(p, t3)
    compute(t1, S1);
    tcur = t2; t1 = t3;
  }
  if (active && store_en) {
#pragma unroll
    for (int qt = 0; qt < QT; ++qt) {
      float lt = redg(lsum[qt]);
      float inv = 1.f / lt;
      u16* mp = mixp + (size_t)(qrow_w + qt * 16 + l15) * 1024;
#pragma unroll
      for (int dvt = 0; dvt < 4; ++dvt) {
        u16* a = mp + dvt * 16 + g * 4;
        bf16x4 gt4 = *(const bf16x4*)a;
        *(bf16x4*)a = pack4(o[dvt][qt][0] * inv * bf2f((u16)gt4[0]), o[dvt][qt][1] * inv * bf2f((u16)gt4[1]),
                            o[dvt][qt][2] * inv * bf2f((u16)gt4[2]), o[dvt][qt][3] * inv * bf2f((u16)gt4[3]));
      }
    }
  }
}

DI void p2_norm_rows4(const Params& p, int l, int rbase) {
  char* ws = p.ws;
  const int lane = otid() & 63, l15 = lane & 15, g = lane >> 4;
  const int row = rbase + g;
  const u16* z = (const u16*)(ws + W_ZRAW) + (size_t)row * 416;
  int seq, t, pos;
  row_info(row, seq, t, pos);
  const size_t kvrow = seq < 2 ? (size_t)row : (size_t)(PROW + (seq - 2) * 1056 + 1024 + t);
  const uint4 zc0 = *(const uint4*)(z + l15 * 16), zc1 = *(const uint4*)(z + l15 * 16 + 8);
  const uint4 zk = *(const uint4*)(z + 256 + l15 * 8);
  const float ka = bf2f(z[384 + l15]), kb = bf2f(z[400 + l15]);
  {
    const unsigned w[8] = {zc0.x, zc0.y, zc0.z, zc0.w, zc1.x, zc1.y, zc1.z, zc1.w};
    float v[16];
    float ss = 0.f;
#pragma unroll
    for (int i = 0; i < 8; ++i) { v[2 * i] = bf2f((u16)(w[i] & 0xffff)); v[2 * i + 1] = bf2f((u16)(w[i] >> 16)); ss += v[2 * i] * v[2 * i] + v[2 * i + 1] * v[2 * i + 1]; }
    ss = red16(ss);
    const float r = __builtin_amdgcn_rsqf(ss * (1.f / 256.f) + EPSV);
    const float* gp = p.in[10] + l * 256 + l15 * 16;
    unsigned o[8];
#pragma unroll
    for (int i = 0; i < 4; ++i) {
      float4 gg = *(const float4*)(gp + i * 4);
      o[2 * i] = pack2(v[4 * i] * r * gg.x, v[4 * i + 1] * r * gg.y);
      o[2 * i + 1] = pack2(v[4 * i + 2] * r * gg.z, v[4 * i + 3] * r * gg.w);
    }
    u16* d = (u16*)(ws + W_CQ) + (size_t)row * 256 + l15 * 16;
    *(uint4*)d = make_uint4(o[0], o[1], o[2], o[3]);
    *(uint4*)(d + 8) = make_uint4(o[4], o[5], o[6], o[7]);
  }
  {
    const unsigned w[4] = {zk.x, zk.y, zk.z, zk.w};
    float v[8];
    float ss = 0.f;
#pragma unroll
    for (int i = 0; i < 4; ++i) { v[2 * i] = bf2f((u16)(w[i] & 0xffff)); v[2 * i + 1] = bf2f((u16)(w[i] >> 16)); ss += v[2 * i] * v[2 * i] + v[2 * i + 1] * v[2 * i + 1]; }
    ss = red16(ss);
    const float r = __builtin_amdgcn_rsqf(ss * (1.f / 128.f) + EPSV);
    const float* gp = p.in[14] + l * 128 + l15 * 8;
    const float4 g0 = *(const float4*)gp, g1 = *(const float4*)(gp + 4);
    const float o0 = v[0] * r * g0.x, o1 = v[1] * r * g0.y, o2 = v[2] * r * g0.z, o3 = v[3] * r * g0.w;
    const float o4 = v[4] * r * g1.x, o5 = v[5] * r * g1.y, o6 = v[6] * r * g1.z, o7 = v[7] * r * g1.w;
    *(uint4*)((u16*)(ws + W_CKV) + kvrow * 128 + l15 * 8) = make_uint4(pack2(o0, o1), pack2(o2, o3), pack2(o4, o5), pack2(o6, o7));
    float* dst = (seq < 2 ? p.out + O_PCKV + ((size_t)(l * 2 + seq) * 8192 + t) * 128 : p.out + O_SCKV + ((size_t)(l * 32 + seq - 2) * 32 + t) * 128) + l15 * 8;
    ntst4(dst, make_float4(o0, o1, o2, o3));
    ntst4(dst + 4, make_float4(o4, o5, o6, o7));
  }
  {
    const float ss = red16(ka * ka + kb * kb);
    const float r = __builtin_amdgcn_rsqf(ss * (1.f / 32.f) + EPSV);
    const float y1 = ka * r * p.in[15][l * 32 + l15], y2 = kb * r * p.in[15][l * 32 + 16 + l15];
    float c, sn;
    rope_cs(pos, l15, -LOG2_1E4 / 16.f, c, sn);
    const float o1 = y1 * c - y2 * sn, o2 = y1 * sn + y2 * c;
    u16* kd = (u16*)(ws + W_KR) + kvrow * 32;
    kd[l15] = f2bf(o1);
    kd[16 + l15] = f2bf(o2);
    float* dst = seq < 2 ? p.out + O_PKR + ((size_t)(l * 2 + seq) * 8192 + t) * 32 : p.out + O_SKR + ((size_t)(l * 32 + seq - 2) * 32 + t) * 32;
    dst[l15] = o1;
    dst[16 + l15] = o2;
  }
}

DI void p2_kvc(const Params& p, int idx) {
  char* ws = p.ws;
  const int lane = otid() & 63, l15 = lane & 15, g = lane >> 4;
  const u16* vt = (const u16*)(ws + W_RETVT);
  const u16* kz = (const u16*)(ws + W_RETKZT);
  size_t base; int stride, nks;
  if (idx < 1024) { int sh = idx >> 7, c = idx & 127; base = (size_t)sh * 64 * 8192 + c * 64; stride = 8192; nks = 2; }
  else { base = 4194304ull + (size_t)(idx - 1024) * 64 * 32; stride = 32; nks = 1; }
  f32x4 acc[4][4];
#pragma unroll
  for (int mt = 0; mt < 4; ++mt)
#pragma unroll
    for (int nt = 0; nt < 4; ++nt) acc[mt][nt] = f32x4{0.f, 0.f, 0.f, 0.f};
  for (int ks = 0; ks < nks; ++ks) {
    bf16x8 af[4], bfr[4];
#pragma unroll
    for (int mt = 0; mt < 4; ++mt) af[mt] = *(const bf16x8*)(vt + base + (size_t)(mt * 16 + l15) * stride + ks * 32 + g * 8);
#pragma unroll
    for (int nt = 0; nt < 4; ++nt) bfr[nt] = *(const bf16x8*)(kz + base + (size_t)(nt * 16 + l15) * stride + ks * 32 + g * 8);
#pragma unroll
    for (int mt = 0; mt < 4; ++mt)
#pragma unroll
      for (int nt = 0; nt < 4; ++nt) acc[mt][nt] = MFMA(af[mt], bfr[nt], acc[mt][nt]);
  }
  float* dst = (float*)(ws + W_KVC) + (size_t)idx * 4096;
#pragma unroll
  for (int mt = 0; mt < 4; ++mt)
#pragma unroll
    for (int nt = 0; nt < 4; ++nt)
#pragma unroll
      for (int j = 0; j < 4; ++j) dst[(mt * 16 + g * 4 + j) * 64 + nt * 16 + l15] = acc[mt][nt][j];
}

DI void phase2(const Params& p, int l, char* smem, int* ctr, int* s_item, int xcd, bool store_en = true) {
  char* ws = p.ws;
  const int tid = otid(), wave = __builtin_amdgcn_readfirstlane(tid >> 6);
  float* bias_s = (float*)(smem + 2 * (64 * 72 + 64 * VS) * 2);
  constexpr int N_BP = 128, N_BS = 16, N_KVC = 36, N_NORM = 68;
  constexpr int N_ALL = N_BP + N_BS + N_KVC + N_NORM;
  for (int qi = 0; qi < 8; ++qi) {
    const int xq = (xcd + qi) & 7;
    for (;;) {
      __syncthreads();
      if (tid == 0) *s_item = atomicAdd(ctr + xq * 32, 1);
      __syncthreads();
      const int it = __builtin_amdgcn_readfirstlane(*s_item);
      if (it >= N_ALL) break;
      if (it < N_BP + N_BS) {
        int seq, h, qrow0, nq, ktb, kte, kvlen, qpos0, kpos0;
        size_t kbase;
        if (it < N_BP) {
          int c = 127 - it, sh = xq;
          seq = sh >> 2; h = sh & 3;
          qrow0 = seq * 8192 + c * 64; nq = 64;
          ktb = c - 8 < 0 ? 0 : c - 8; kte = c + 1; kvlen = 8192;
          qpos0 = c * 64; kpos0 = 0;
          kbase = (size_t)seq * 8192;
        } else {
          int j = xq * 16 + (it - N_BP);
          seq = 2 + (j >> 2); h = j & 3;
          qrow0 = PROW + (seq - 2) * 32; nq = 32;
          ktb = 0; kte = 9; kvlen = 544;
          qpos0 = 1024; kpos0 = 512;
          kbase = (size_t)PROW + (size_t)(seq - 2) * 544;
        }
        const float* bb = p.in[20] + (size_t)(l * 4 + h) * 257;
        for (int i = tid; i < 257; i += 256) bias_s[i] = bb[i] * LOG2E;
        const u16* bq = (const u16*)(ws + W_BQ) + (size_t)qrow0 * 256 + h * 64;
        const u16* bk = (const u16*)(ws + W_BK) + kbase * 256 + h * 64;
        const u16* bvt = (const u16*)(ws + W_BVT) + band_t_addr(seq, 0, h, 0);
        u16* mix = (u16*)(ws + W_GATE) + (size_t)qrow0 * 1024 + 768 + h * 64;
        attn_item<64, 1, true, false>(bq, 256, nq, bk, 256, nullptr, 0, bvt, seq < 2 ? 8192 : 544, ktb, kte, kvlen, -1,
                                      0.125f * LOG2E, 0.f, bias_s, qpos0, kpos0, mix, smem, (const u16*)(ws + W_CTR + 3968), store_en);
      } else if (it < N_BP + N_BS + N_KVC) {
        p2_kvc(p, (xq * N_KVC + it - N_BP - N_BS) * 4 + wave);
      } else {
        int r0 = (xq * N_NORM + it - N_BP - N_BS - N_KVC) * 32 + wave * 8;
        p2_norm_rows4(p, l, r0);
        p2_norm_rows4(p, l, r0 + 4);
      }
    }
  }
}

DI void phase3(const Params& p, int l, char* smem, int* ctr, int* s_item, int xcd) {
  char* ws = p.ws;
  const int G = gridDim.x, bid = blockIdx.x, tid = otid();
  const int lane = tid & 63, wave = tid >> 6, wm = wave >> 1, wn = wave & 1, l15 = lane & 15, g = lane >> 4;
  for (int it = bid; it < 256; it += G) {
    const float* __restrict__ kvc = (const float*)(ws + W_KVC);
    if (it < 128) {
      int sh = it >> 4, el = (it & 15) * 256 + tid, h = sh & 3;
      float g64 = ex2(gamma_lg2(h) * 64.f);
      u16* __restrict__ sst = (u16*)(ws + W_SST);
      float S = 0.f;
      for (int c0 = 0; c0 < 128; c0 += 16) {
        float kv[16];
#pragma unroll
        for (int j = 0; j < 16; ++j) kv[j] = kvc[(size_t)(sh * 128 + c0 + j) * 4096 + el];
#pragma unroll
        for (int j = 0; j < 16; ++j) {
          sst[(size_t)(sh * 128 + c0 + j) * 4096 + el] = f2bf(S);
          S = g64 * S + kv[j];
        }
      }
      int e = el >> 6, d = el & 63;
      p.out[O_PSTATE + (size_t)(l * 8 + sh) * 4096 + d * 64 + e] = S;
    } else {
      int bh = it - 128, h = bh & 3;
      float g32 = ex2(gamma_lg2(h) * 32.f);
      const float* __restrict__ sin_ = p.in[2] + (size_t)(l * 128 + bh) * 4096;
      float a0[16], a1[16];
#pragma unroll
      for (int i = 0; i < 16; ++i) {
        int el = i * 256 + tid, d = el >> 6, e = el & 63;
        a0[i] = sin_[el];
        a1[i] = kvc[(size_t)(1024 + bh) * 4096 + e * 64 + d];
      }
#pragma unroll
      for (int i = 0; i < 16; ++i) p.out[O_SSTATE + (size_t)(l * 128 + bh) * 4096 + i * 256 + tid] = g32 * a0[i] + a1[i];
    }
  }
  gemm_tiles_dyn(ctr, s_item, xcd, 392, 8, [&](int mp, int n) {
    f32x4 acc[4][4];
    gemm_core((const u16*)(ws + W_CKV), 128, (const u16*)(ws + W_WUKV), 128, 128, mp * 128, n * 128, acc, smem);
    const int rb = mp * 128 + wm * 64, h = n, m0 = mp * 128;
    u16* T = (u16*)smem;
    u16* T2 = T + 128 * TS;
    __syncthreads();
    if (wn == 0) {
      const float* gn = p.in[17] + l * 64;
      float gv[4];
#pragma unroll
      for (int nt = 0; nt < 4; ++nt) gv[nt] = gn[nt * 16 + l15];
#pragma unroll
      for (int mt = 0; mt < 4; ++mt)
#pragma unroll
        for (int j = 0; j < 4; ++j) {
          float ss = 0.f;
#pragma unroll
          for (int nt = 0; nt < 4; ++nt) ss += acc[mt][nt][j] * acc[mt][nt][j];
          ss = red16(ss);
          float r = __builtin_amdgcn_rsqf(ss * (1.f / 64.f) + EPSV);
#pragma unroll
          for (int nt = 0; nt < 4; ++nt) stage_rm(T, wm, 0, g, l15, mt, nt, j, acc[mt][nt][j] * r * gv[nt]);
        }
    } else {
#pragma unroll
      for (int mt = 0; mt < 4; ++mt)
#pragma unroll
        for (int nt = 0; nt < 4; ++nt) stage_tr(T2, wm, 0, g, l15, mt, nt, acc[mt][nt]);
    }
    (void)rb;
    __syncthreads();
    {
      u16* kn = (u16*)(ws + W_KNOPE) + (size_t)m0 * 512 + h * 64;
      tile_copy_out<128, 8>(T, tid, [&](int lr, int cc) { return kn + (size_t)lr * 512 + cc * 8; });
      u16* vt = (u16*)(ws + W_VT);
      tile_copy_out<64, 16>(T2, tid, [&](int lr, int cc) {
        int row = m0 + cc * 8, seq, tk;
        if (row < PROW) { seq = row >> 13; tk = row & 8191; }
        else { int r = row - PROW; int s2 = r / 1056; seq = 2 + s2; tk = r - s2 * 1056; }
        return vt + mla_t_addr(seq, tk, h, lr);
      });
    }
  });
  gemm_tiles_dyn(ctr + 1, s_item, xcd, 136, 6, [&](int mp, int n) {
    f32x4 acc[4][4];
    gemm_core((const u16*)(ws + W_CQ), 256, (const u16*)(ws + W_WUQ), 256, 256, mp * 128, n * 128, acc, smem);
    const int rb = mp * 128 + wm * 64, m0 = mp * 128;
    u16* qm = (u16*)(ws + W_H) + (size_t)m0 * 768;
    u16* T = (u16*)smem;
    __syncthreads();
    if (n < 4) {
      const float* gn = p.in[12] + l * 64;
      float gv[4];
#pragma unroll
      for (int nt = 0; nt < 4; ++nt) gv[nt] = gn[nt * 16 + l15];
#pragma unroll
      for (int mt = 0; mt < 4; ++mt)
#pragma unroll
        for (int j = 0; j < 4; ++j) {
          float ss = 0.f;
#pragma unroll
          for (int nt = 0; nt < 4; ++nt) ss += acc[mt][nt][j] * acc[mt][nt][j];
          ss = red16(ss);
          float r = __builtin_amdgcn_rsqf(ss * (1.f / 64.f) + EPSV);
#pragma unroll
          for (int nt = 0; nt < 4; ++nt) stage_rm(T, wm, wn, g, l15, mt, nt, j, acc[mt][nt][j] * r * gv[nt]);
        }
      __syncthreads();
      tile_copy_out<128, 16>(T, tid, [&](int lr, int cc) { return qm + (size_t)lr * 768 + (2 * n + (cc >> 3)) * 96 + (cc & 7) * 8; });
    } else {
      const float* gn = p.in[13] + l * 32;
      const float g0 = gn[l15], g1 = gn[16 + l15];
#pragma unroll
      for (int mt = 0; mt < 4; ++mt)
#pragma unroll
        for (int j = 0; j < 4; ++j) {
          int row = rb + mt * 16 + g * 4 + j, seq, t, pos;
          row_info(row, seq, t, pos);
          float c, sn;
          rope_cs(pos, l15, -LOG2_1E4 / 16.f, c, sn);
#pragma unroll
          for (int hp = 0; hp < 2; ++hp) {
            float a0 = acc[mt][2 * hp][j], a1 = acc[mt][2 * hp + 1][j];
            float ss = red16(a0 * a0 + a1 * a1);
            float r = __builtin_amdgcn_rsqf(ss * (1.f / 32.f) + EPSV);
            float x1 = a0 * r * g0, x2 = a1 * r * g1;
            u16* tp = T + (wm * 64 + mt * 16 + g * 4 + j) * TS + wn * 64 + hp * 32 + l15;
            tp[0] = f2bf(x1 * c - x2 * sn);
            tp[16] = f2bf(x1 * sn + x2 * c);
          }
        }
      __syncthreads();
      const int hb = (n * 128 - 512) >> 5;
      tile_copy_out<128, 16>(T, tid, [&](int lr, int cc) { return qm + (size_t)lr * 768 + (hb + (cc >> 2)) * 96 + 64 + (cc & 3) * 8; });
    }
  });
}

DI void p4_ret(const Params& p, int l, int idx, int qt, bool store_en = true) {
  char* ws = p.ws;
  const int lane = otid() & 63, l15 = lane & 15, g = lane >> 4;
  int seq, h, row0, L, stride;
  size_t tbase;
  if (idx < 1024) { int sh = idx >> 7, c = idx & 127; seq = sh >> 2; h = sh & 3; row0 = seq * 8192 + c * 64; L = 64; stride = 8192; tbase = (size_t)sh * 64 * 8192 + c * 64; }
  else { int j = idx - 1024; seq = 2 + (j >> 2); h = j & 3; row0 = PROW + (seq - 2) * 32; L = 32; stride = 32; tbase = 4194304ull + (size_t)j * 64 * 32; }
  const float lg = gamma_lg2(h);
  const u16* rq = (const u16*)(ws + W_RETQ);
  const u16* rk = (const u16*)(ws + W_RETK);
  const u16* vt = (const u16*)(ws + W_RETVT) + tbase;
  const u16* sst = (const u16*)(ws + W_SST) + (size_t)idx * 4096;
  bf16x8 qf[2];
#pragma unroll
  for (int ks = 0; ks < 2; ++ks) qf[ks] = *(const bf16x8*)(rq + (size_t)(row0 + qt * 16 + l15) * 256 + h * 64 + ks * 32 + g * 8);
  f32x4 st[4];
#pragma unroll
  for (int kt = 0; kt < 4; ++kt) st[kt] = f32x4{0.f, 0.f, 0.f, 0.f};
  const int lq = qt * 16 + l15;
  const int nkt = L >> 4;
#pragma unroll
  for (int kt = 0; kt < 4; ++kt) {
    const int ktc = kt < nkt ? kt : 0;
#pragma unroll
    for (int ks = 0; ks < 2; ++ks) {
      bf16x8 kf = *(const bf16x8*)(rk + (size_t)(row0 + ktc * 16 + l15) * 256 + h * 64 + ks * 32 + g * 8);
      st[kt] = MFMA(kf, qf[ks], st[kt]);
    }
#pragma unroll
    for (int j = 0; j < 4; ++j) {
      int m = kt * 16 + g * 4 + j;
      st[kt][j] = lq >= m ? st[kt][j] * ex2(lg * (float)(lq - m)) : 0.f;
    }
  }
  f32x4 o[4], o2[4];
#pragma unroll
  for (int et = 0; et < 4; ++et) { o[et] = f32x4{0.f, 0.f, 0.f, 0.f}; o2[et] = f32x4{0.f, 0.f, 0.f, 0.f}; }
#pragma unroll
  for (int si = 0; si < 2; ++si) {
    const int so = (si * 32 < L) ? si * 32 : 0;
    uint4 u = make_uint4(pack2(st[2 * si][0], st[2 * si][1]), pack2(st[2 * si][2], st[2 * si][3]),
                         pack2(st[2 * si + 1][0], st[2 * si + 1][1]), pack2(st[2 * si + 1][2], st[2 * si + 1][3]));
    bf16x8 pf = __builtin_bit_cast(bf16x8, u);
#pragma unroll
    for (int et = 0; et < 4; ++et) {
      bf16x4 lo = *(const bf16x4*)(vt + (size_t)(et * 16 + l15) * stride + so + g * 4);
      bf16x4 hi = *(const bf16x4*)(vt + (size_t)(et * 16 + l15) * stride + so + 16 + g * 4);
      bf16x8 vf = __builtin_shufflevector(lo, hi, 0, 1, 2, 3, 4, 5, 6, 7);
      o[et] = MFMA(vf, pf, o[et]);
    }
  }
#pragma unroll
  for (int et = 0; et < 4; ++et)
#pragma unroll
    for (int ks = 0; ks < 2; ++ks) {
      bf16x8 sf = *(const bf16x8*)(sst + (et * 16 + l15) * 64 + ks * 32 + g * 8);
      o2[et] = MFMA(sf, qf[ks], o2[et]);
    }
  const float xi = ex2(lg * (float)(lq + 1));
  float ss = 0.f;
#pragma unroll
  for (int et = 0; et < 4; ++et)
#pragma unroll
    for (int j = 0; j < 4; ++j) { float v = o[et][j] + o2[et][j] * xi; o[et][j] = v; ss += v * v; }
  ss = redg(ss);
  const float r = __builtin_amdgcn_rsqf(ss * (1.f / 64.f) + EPSV);
  const float* gn = p.in[9] + l * 256 + h * 64;
  u16* mp = (u16*)(ws + W_GATE) + (size_t)(row0 + lq) * 1024 + h * 64;
  if (store_en)
#pragma unroll
  for (int et = 0; et < 4; ++et) {
    u16* a = mp + et * 16 + g * 4;
    float4 gg = *(const float4*)(gn + et * 16 + g * 4);
    bf16x4 gt4 = *(const bf16x4*)a;
    *(bf16x4*)a = pack4(o[et][0] * r * gg.x * bf2f((u16)gt4[0]), o[et][1] * r * gg.y * bf2f((u16)gt4[1]),
                        o[et][2] * r * gg.z * bf2f((u16)gt4[2]), o[et][3] * r * gg.w * bf2f((u16)gt4[3]));
  }
}

DI void phase4(const Params& p, int l, char* smem, int* ctr, int* s_item, int xcd, bool store_en = true) {
  char* ws = p.ws;
  const int tid = otid(), wave = __builtin_amdgcn_readfirstlane(tid >> 6), lane = tid & 63;
  constexpr int N_MP = 128, N_MS = 32, N_RP = 128, N_RS = 8;
  constexpr int N_ALL = N_MP + N_MS + N_RP + N_RS;
  const float sc = 0.10206207261596575f * LOG2E;
  float mshift;
  {
    float a = fabsf(p.in[12][l * 64 + lane]), b = fabsf(p.in[13][l * 32 + (lane & 31)]);
    float c = fabsf(p.in[17][l * 64 + lane]), d = fabsf(p.in[15][l * 32 + (lane & 31)]);
#pragma unroll
    for (int o = 32; o; o >>= 1) {
      a = fmaxf(a, __shfl_xor(a, o)); b = fmaxf(b, __shfl_xor(b, o));
      c = fmaxf(c, __shfl_xor(c, o)); d = fmaxf(d, __shfl_xor(d, o));
    }
    mshift = sc * 1.02f * sqrtf((64.f * a * a + 32.f * b * b) * (64.f * c * c + 32.f * d * d));
  }
  for (int qi = 0; qi < 8; ++qi) {
    const int xq = (xcd + qi) & 7;
    for (;;) {
      __syncthreads();
      if (tid == 0) *s_item = atomicAdd(ctr + xq * 32, 1);
      __syncthreads();
      const int it = __builtin_amdgcn_readfirstlane(*s_item);
      if (it >= N_ALL) break;
      if (it < N_MP) {
        const int ip = it;
        int qb = 63 - (ip & 63), sh = xq * 2 + (ip >> 6);
        int seq = sh >> 3, h = sh & 7;
        int qrow0 = seq * 8192 + qb * 128;
        size_t kb = (size_t)seq * 8192;
        const u16* q = (const u16*)(ws + W_H) + (size_t)qrow0 * 768 + h * 96;
        const u16* kn = (const u16*)(ws + W_KNOPE) + kb * 512 + h * 64;
        const u16* kr = (const u16*)(ws + W_KR) + kb * 32;
        const u16* vt = (const u16*)(ws + W_VT) + mla_t_addr(seq, 0, h, 0);
        u16* mix = (u16*)(ws + W_GATE) + (size_t)qrow0 * 1024 + 256 + h * 64;
        attn_item<96, 2, false, true>(q, 768, 128, kn, 512, kr, 32, vt, 8192, 0, qb * 2 + 2, 8192, qb * 2, sc, mshift, nullptr, 0, 0, mix, smem, (const u16*)(ws + W_CTR + 3968), store_en,
                                      (int)((unsigned)(qb * 29 + 7) % (unsigned)(qb * 2 + 2)));
      } else if (it < N_MP + N_MS) {
        int j = xq * N_MS + it - N_MP, b = j >> 3, h = j & 7, seq = 2 + b;
        int qrow0 = PROW + b * 32;
        size_t kb = (size_t)PROW + (size_t)b * 1056;
        const u16* q = (const u16*)(ws + W_H) + (size_t)qrow0 * 768 + h * 96;
        const u16* kn = (const u16*)(ws + W_KNOPE) + kb * 512 + h * 64;
        const u16* kr = (const u16*)(ws + W_KR) + kb * 32;
        const u16* vt = (const u16*)(ws + W_VT) + mla_t_addr(seq, 0, h, 0);
        u16* mix = (u16*)(ws + W_GATE) + (size_t)qrow0 * 1024 + 256 + h * 64;
        attn_item<96, 1, false, false>(q, 768, 32, kn, 512, kr, 32, vt, 1056, 0, 17, 1056, -1, sc, 0.f, nullptr, 0, 0, mix, smem, (const u16*)(ws + W_CTR + 3968), store_en);
      } else {
        int j = it - N_MP - N_MS;
        int idx = j < N_RP ? xq * N_RP + j : 1024 + (xq * N_RS + j - N_RP) * 2 + (wave >> 1);
        int qt = j < N_RP ? wave : (wave & 1);
        p4_ret(p, l, idx, qt, store_en);
      }
    }
  }
}

__global__ void __launch_bounds__(256, 2) mega(Params p) {
  cg::grid_group grid = cg::this_grid();
  __shared__ __attribute__((aligned(16))) char smem[65536];
  __shared__ int s_item;
  __shared__ uint4 xb_words;
  char* ws = p.ws;
  int* ctr = (int*)(ws + W_CTR);
  if (__builtin_amdgcn_workitem_id_x() == 0) xb_words = make_uint4(0u, 0u, 0u, 0u);
  __syncthreads();
  const XcdBarrier xb = xcd_barrier_post((unsigned*)(ws + W_BAR), (volatile LAS unsigned*)&xb_words);
  if (gridDim.x > 65535u) grid.sync();
  const int wave = otid() >> 6, lane = otid() & 63;
  const int wm = wave >> 1, wn = wave & 1, l15 = lane & 15, g = lane >> 4;
  for (int l0 = 0; l0 < 2; ++l0) {
    const int l = olayer(l0);
    phase0(p, l, smem);
    if (DUP == 10) phase0(p, l, smem);
    xcd_barrier(xb);
    if (DUP == 9) { for (int i = 0; i < 5; ++i) xcd_barrier(xb); }
    gemm_tiles_dyn(ctr + 8 + l, &s_item, xb.x & 7, 136, 24, [&](int mp, int n) {
      f32x4 acc[4][4];
      if (DUP == 11) gemm_core((const u16*)(ws + W_H), 1024, (const u16*)(ws + W_WIN), 1024, 1024, mp * 128, n * 128, acc, smem);
      gemm_core((const u16*)(ws + W_H), 1024, (const u16*)(ws + W_WIN), 1024, 1024, mp * 128, n * 128, acc, smem);
      phase1_epilogue(p, l, acc, mp * 128, n * 128, smem);
    });
    if (DUP == 1) {
      for_gemm_tiles(136, 24, [&](int mp, int n) {
        f32x4 acc[4][4];
        gemm_core((const u16*)(ws + W_H), 1024, (const u16*)(ws + W_WIN), 1024, 1024, mp * 128, n * 128, acc, smem);
        phase1_epilogue(p, l, acc, mp * 128, n * 128, smem);
      });
    }
    xcd_barrier(xb);
    if (DUP == 2) phase2(p, l, smem, ctr + 512 + l * 2, &s_item, xb.x & 7, ctr[1000] != 0);
    phase2(p, l, smem, ctr + l * 2, &s_item, xb.x & 7);
    xcd_barrier(xb);
    phase3(p, l, smem, ctr + 4 + l * 2, &s_item, xb.x & 7);
    if (DUP == 3) phase3(p, l, smem, ctr + 516 + l * 2, &s_item, xb.x & 7);
    xcd_barrier(xb);
    if (DUP == 4) phase4(p, l, smem, ctr + 512 + l * 2 + 1, &s_item, xb.x & 7, ctr[1000] != 0);
    phase4(p, l, smem, ctr + l * 2 + 1, &s_item, xb.x & 7);
    xcd_barrier(xb);
    for (int rep = 0; rep < ((DUP == 5 && l == 0) ? 2 : 1); ++rep)
    for_gemm_tiles(136, 8, [&](int mp, int n) {
      f32x4 acc[4][4];
      gemm_core((const u16*)(ws + W_GATE), 1024, (const u16*)(ws + W_WOUT), 1024, 1024, mp * 128, n * 128, acc, smem);
      const int m0 = mp * 128, n0 = n * 128, tid5 = otid();
      float* Tf = (float*)smem;
      const float* xb = (l == 0) ? (m0 < PROW ? p.in[0] + (size_t)m0 * 1024 : p.in[1] + (size_t)(m0 - PROW) * 1024)
                                 : p.out + O_Y + (size_t)m0 * 1024;
      float* yb = p.out + O_Y + (size_t)m0 * 1024;
#pragma unroll
      for (int pass = 0; pass < 2; ++pass) {
        __syncthreads();
        if (wm == pass) {
#pragma unroll
          for (int mt = 0; mt < 4; ++mt)
#pragma unroll
            for (int nt = 0; nt < 4; ++nt)
#pragma unroll
              for (int j = 0; j < 4; ++j) Tf[(mt * 16 + g * 4 + j) * 132 + wn * 64 + nt * 16 + l15] = acc[mt][nt][j];
        }
        __syncthreads();
#pragma unroll
        for (int i = 0; i < 8; ++i) {
          int q = tid5 + i * 256, lr = q >> 5, cc = q & 31;
          size_t off = (size_t)(pass * 64 + lr) * 1024 + n0 + cc * 4;
          float4 tv = *(const float4*)(Tf + lr * 132 + cc * 4);
          float4 xv = ntld4(xb + off);
          float4 yv = make_float4(xv.x + tv.x, xv.y + tv.y, xv.z + tv.z, xv.w + tv.w);
          ntst4(yb + off, yv);
        }
      }
    });
    if (l0 == 0) xcd_barrier(xb);
  }
}

extern "C" void kernel_launch(void* const* d_in, const int* in_sizes, int n_in, void* d_out, int out_size, void* d_ws,
                              size_t ws_size, hipStream_t stream) {
  static int grid_blocks = 0;
  if (!grid_blocks) {
    int dev = 0, cus = 0, per_cu = 0;
    hipGetDevice(&dev);
    hipDeviceGetAttribute(&cus, hipDeviceAttributeMultiprocessorCount, dev);
    hipOccupancyMaxActiveBlocksPerMultiprocessor(&per_cu, mega, 256, 0);
    if (per_cu > 2) per_cu = 2;
    if (per_cu < 1) per_cu = 1;
    grid_blocks = cus * per_cu;
  }
  Params p{};
  for (int i = 0; i < 22; ++i) p.in[i] = (const float*)d_in[i];
  p.out = (float*)d_out;
  p.ws = (char*)d_ws;
  hipMemsetAsync((char*)d_ws + W_CTR, 0, 4096 + 16384, stream);
  void* args[] = {&p};
  hipError_t e = hipLaunchCooperativeKernel((void*)mega, dim3(grid_blocks), dim3(256), args, 0, stream);
  if (e != hipSuccess) fprintf(stderr, "cooperative launch failed: %s (grid %d)\n", hipGetErrorString(e), grid_blocks);
}
```
